# Optimizing an MI355X kernel written in HIP

```python
import math
import jax, jax.numpy as jnp
from jax import lax
import numpy as np

D_MODEL = 1024
BATCH = 1
SEQ = 16384
DEPTH = 4

N_MIXERS = 4
HEAD_DIM = 64
N_HEADS = D_MODEL // HEAD_DIM
D_FF = 4 * D_MODEL
Q_BLOCK = 128
ROPE_THETA = 500000.0
ROT_DIM = HEAD_DIM // 4
RMS_EPS = 1e-6
NEG_INF = -1e30
FORCE_SCORE = 1e9
POOL_WINDOWS = (2, 4, 8, 16)
POOL_GROUP = D_MODEL // len(POOL_WINDOWS)
CONV_WIDTH = 3
NSA_KV_HEADS = 4
NSA_GROUP = N_HEADS // NSA_KV_HEADS
CMP_BLOCK = 32
CMP_STRIDE = 16
SLC_BLOCK = 64
SLC_TOPK = 16
WIN = 512
CMP_HIDDEN = 256

kernel_name = "hybrid_fox_pool_conv_nsa_trunk"


def rmsnorm(x, g):
    xf = x.astype(jnp.float32)
    y = xf * lax.rsqrt(jnp.mean(xf * xf, axis=-1, keepdims=True) + RMS_EPS)
    return (y * g.astype(jnp.float32)).astype(x.dtype)


def rope_tables(positions):
    inv = ROPE_THETA ** (-jnp.arange(0, ROT_DIM, 2, dtype=jnp.float32) / ROT_DIM)
    ang = positions.astype(jnp.float32)[:, None] * inv[None, :]
    return jnp.cos(ang), jnp.sin(ang)


def apply_partial_rope(x, cos, sin):
    half = ROT_DIM // 2
    x1, x2, xp = x[..., :half], x[..., half:ROT_DIM], x[..., ROT_DIM:]
    c = cos[None, :, None, :].astype(x.dtype)
    s = sin[None, :, None, :].astype(x.dtype)
    return jnp.concatenate([x1 * c - x2 * s, x2 * c + x1 * s, xp], axis=-1)


def sq_relu_mlp(h, w1, w2):
    return jnp.square(jax.nn.relu(h @ w1)) @ w2


def fox_attention(h, w_qkv, w_f, b_f, w_o):
    B, S, D = h.shape
    q, k, v = jnp.split(h @ w_qkv, 3, axis=-1)
    q = q.reshape(B, S, N_HEADS, HEAD_DIM)
    k = k.reshape(B, S, N_HEADS, HEAD_DIM)
    v = v.reshape(B, S, N_HEADS, HEAD_DIM)
    log_f = jax.nn.log_sigmoid((h @ w_f + b_f).astype(jnp.float32))
    cum = jnp.cumsum(log_f, axis=1)
    cum_t = cum.transpose(0, 2, 1)
    nblk = S // Q_BLOCK
    scale = HEAD_DIM ** -0.5
    key_pos = jnp.arange(S, dtype=jnp.int32)
    q_blocks = q.reshape(B, nblk, Q_BLOCK, N_HEADS, HEAD_DIM).swapaxes(0, 1)
    c_blocks = cum.reshape(B, nblk, Q_BLOCK, N_HEADS).swapaxes(0, 1)
    starts = jnp.arange(nblk, dtype=jnp.int32) * Q_BLOCK

    def block(args):
        q_i, c_i, s0 = args
        logits = jnp.einsum('bqhd,bkhd->bhqk', q_i, k, preferred_element_type=jnp.float32) * scale
        logits = logits + (c_i.transpose(0, 2, 1)[..., :, None] - cum_t[..., None, :])
        qpos = s0 + jnp.arange(Q_BLOCK, dtype=jnp.int32)
        mask = key_pos[None, :] <= qpos[:, None]
        p = jax.nn.softmax(jnp.where(mask, logits, NEG_INF), axis=-1)
        return jnp.einsum('bhqk,bkhd->bqhd', p.astype(v.dtype), v)

    o = lax.map(block, (q_blocks, c_blocks, starts))
    return o.swapaxes(0, 1).reshape(B, S, D) @ w_o


def pool_mixer(h, w_pool, pool_scale):
    B, S, D = h.shape
    hf = h.astype(jnp.float32)
    cs = jnp.concatenate([jnp.zeros((B, 1, D), jnp.float32), jnp.cumsum(hf, axis=1)], axis=1)
    t = jnp.arange(S, dtype=jnp.int32)
    diffs = []
    for g, w in enumerate(POOL_WINDOWS):
        sl = slice(g * POOL_GROUP, (g + 1) * POOL_GROUP)
        lo = jnp.maximum(t + 1 - w, 0)
        cnt = (t + 1 - lo).astype(jnp.float32)
        mean = (cs[:, 1:, sl] - cs[:, lo, sl]) / cnt[None, :, None]
        diffs.append(mean - hf[..., sl])
    d = jnp.stack(diffs, axis=2).astype(h.dtype)
    y = jnp.einsum('bsgi,gio->bsgo', d, w_pool).reshape(B, S, D)
    return y * pool_scale


def short_conv_mixer(h, w_in, conv_w, w_out):
    B, S, D = h.shape
    b_gate, c_gate, u = jnp.split(h @ w_in, 3, axis=-1)
    z = c_gate * u
    zp = jnp.pad(z, ((0, 0), (CONV_WIDTH - 1, 0), (0, 0)))
    conv = conv_w[0] * zp[:, 0:S]
    for j in range(1, CONV_WIDTH):
        conv = conv + conv_w[j] * zp[:, j:j + S]
    return (b_gate * conv) @ w_out


def nsa_attention(h, cos, sin, w_in, pe_k, w1_k, w2_k, pe_v, w1_v, w2_v, w_o):
    B, S, D = h.shape
    qd = N_HEADS * HEAD_DIM
    kvd = NSA_KV_HEADS * HEAD_DIM
    proj = h @ w_in
    q = proj[..., :qd].reshape(B, S, N_HEADS, HEAD_DIM)
    kv = proj[..., qd:qd + 6 * kvd].reshape(B, S, 6, NSA_KV_HEADS, HEAD_DIM)
    gates = jax.nn.sigmoid(proj[..., qd + 6 * kvd:].astype(jnp.float32)).reshape(B, S, 3, NSA_KV_HEADS, NSA_GROUP)
    k_cmp_raw, v_cmp_raw = kv[:, :, 0], kv[:, :, 1]
    k_slc, v_slc = apply_partial_rope(kv[:, :, 2], cos, sin), kv[:, :, 3]
    k_win, v_win = apply_partial_rope(kv[:, :, 4], cos, sin), kv[:, :, 5]
    q = apply_partial_rope(q, cos, sin).reshape(B, S, NSA_KV_HEADS, NSA_GROUP, HEAD_DIM)

    n_cmp = (S - CMP_BLOCK) // CMP_STRIDE + 1
    cmp_idx = np.arange(n_cmp)[:, None] * CMP_STRIDE + np.arange(CMP_BLOCK)[None, :]
    cmp_end = cmp_idx[:, -1]

    def compress(raw, pe, w1, w2):
        blocks = raw[:, cmp_idx] + pe[None, None, :, None, :]
        flat = blocks.transpose(0, 1, 3, 2, 4).reshape(B, n_cmp, NSA_KV_HEADS, CMP_BLOCK * HEAD_DIM)
        return jax.nn.gelu(flat @ w1) @ w2

    k_c = apply_partial_rope(compress(k_cmp_raw, pe_k, w1_k, w2_k), cos[cmp_end], sin[cmp_end])
    v_c = compress(v_cmp_raw, pe_v, w1_v, w2_v)
    cmp_end_j = jnp.asarray(cmp_end, dtype=jnp.int32)

    n_slc = S // SLC_BLOCK
    n_sel = min(SLC_TOPK, n_slc)
    slc_start = np.arange(n_slc) * SLC_BLOCK
    ci = np.arange(n_cmp)[:, None] * CMP_STRIDE
    overlap = jnp.asarray(((ci < slc_start[None, :] + SLC_BLOCK) & (ci + CMP_BLOCK > slc_start[None, :])).astype(np.float32))
    ks_blk = k_slc.reshape(B, n_slc, SLC_BLOCK, NSA_KV_HEADS, HEAD_DIM).transpose(0, 3, 1, 2, 4)
    vs_blk = v_slc.reshape(B, n_slc, SLC_BLOCK, NSA_KV_HEADS, HEAD_DIM).transpose(0, 3, 1, 2, 4)
    b_ix = jnp.arange(B)[:, None, None, None]
    h_ix = jnp.arange(NSA_KV_HEADS)[None, None, :, None]
    blk_ids = jnp.arange(n_slc, dtype=jnp.int32)[None, :]

    pad = jnp.zeros((B, WIN, NSA_KV_HEADS, HEAD_DIM), k_win.dtype)
    k_win_p = jnp.concatenate([pad, k_win], axis=1)
    v_win_p = jnp.concatenate([pad, v_win], axis=1)

    nblk = S // Q_BLOCK
    scale = HEAD_DIM ** -0.5
    q_blocks = q.reshape(B, nblk, Q_BLOCK, NSA_KV_HEADS, NSA_GROUP, HEAD_DIM).swapaxes(0, 1)
    g_blocks = gates.reshape(B, nblk, Q_BLOCK, 3, NSA_KV_HEADS, NSA_GROUP).swapaxes(0, 1)
    starts = jnp.arange(nblk, dtype=jnp.int32) * Q_BLOCK

    def block(args):
        q_i, g_i, s0 = args
        qpos = s0 + jnp.arange(Q_BLOCK, dtype=jnp.int32)
        sc = jnp.einsum('bqkgd,bnkd->bqkgn', q_i, k_c, preferred_element_type=jnp.float32) * scale
        cmask = cmp_end_j[None, :] <= qpos[:, None]
        sc = jnp.where(cmask[None, :, None, None, :], sc, NEG_INF)
        p_c = jnp.where(cmask.any(-1)[None, :, None, None, None], jax.nn.softmax(sc, axis=-1), 0.0)
        o_c = jnp.einsum('bqkgn,bnkd->bqkgd', p_c.astype(v_c.dtype), v_c)
        imp = jnp.einsum('bqkgn,nj->bqkj', p_c, overlap)
        cur = (qpos // SLC_BLOCK)[:, None]
        forced = (blk_ids == 0) | (blk_ids == cur) | (blk_ids == cur - 1)
        valid = blk_ids * SLC_BLOCK <= qpos[:, None]
        imp = jnp.where(forced[None, :, None, :], FORCE_SCORE, imp)
        imp = jnp.where(valid[None, :, None, :], imp, NEG_INF)
        top_val, top_idx = lax.top_k(imp, n_sel)
        ks = ks_blk[b_ix, h_ix, top_idx]
        vs = vs_blk[b_ix, h_ix, top_idx]
        ss = jnp.einsum('bqkgd,bqknld->bqkgnl', q_i, ks, preferred_element_type=jnp.float32) * scale
        tok = top_idx[..., None] * SLC_BLOCK + jnp.arange(SLC_BLOCK, dtype=jnp.int32)
        smask = (top_val > 0.5 * NEG_INF)[..., None] & (tok <= qpos[None, :, None, None, None])
        ss = jnp.where(smask[:, :, :, None], ss, NEG_INF).reshape(B, Q_BLOCK, NSA_KV_HEADS, NSA_GROUP, n_sel * SLC_BLOCK)
        p_s = jax.nn.softmax(ss, axis=-1)
        o_s = jnp.einsum('bqkgm,bqkmd->bqkgd', p_s.astype(vs.dtype),
                         vs.reshape(B, Q_BLOCK, NSA_KV_HEADS, n_sel * SLC_BLOCK, HEAD_DIM))
        kw = lax.dynamic_slice_in_dim(k_win_p, s0, WIN + Q_BLOCK, axis=1)
        vw = lax.dynamic_slice_in_dim(v_win_p, s0, WIN + Q_BLOCK, axis=1)
        kpos = s0 - WIN + jnp.arange(WIN + Q_BLOCK, dtype=jnp.int32)
        wmask = (kpos[None, :] <= qpos[:, None]) & (kpos[None, :] > qpos[:, None] - WIN) & (kpos[None, :] >= 0)
        sw = jnp.einsum('bqkgd,bmkd->bqkgm', q_i, kw, preferred_element_type=jnp.float32) * scale
        p_w = jax.nn.softmax(jnp.where(wmask[None, :, None, None, :], sw, NEG_INF), axis=-1)
        o_w = jnp.einsum('bqkgm,bmkd->bqkgd', p_w.astype(vw.dtype), vw)
        g = g_i.astype(o_c.dtype)[..., None]
        return g[:, :, 0] * o_c + g[:, :, 1] * o_s + g[:, :, 2] * o_w

    o = lax.map(block, (q_blocks, g_blocks, starts))
    return o.swapaxes(0, 1).reshape(B, S, qd) @ w_o


def setup_inputs(seed: int = 0) -> dict:
    key = jax.random.key(seed)
    ks = iter(jax.random.split(key, 64))

    def dense(shape, fan_in):
        return jax.random.normal(next(ks), shape, jnp.float32) * fan_in ** -0.5

    def gain():
        return 1.0 + 0.05 * jax.random.normal(next(ks), (D_MODEL,), jnp.float32)

    nsa_in_width = N_HEADS * HEAD_DIM + 6 * NSA_KV_HEADS * HEAD_DIM + 3 * N_HEADS
    return {
        "x": jax.random.normal(next(ks), (BATCH, SEQ, D_MODEL), jnp.float32),
        "positions": jnp.arange(SEQ, dtype=jnp.int32),
        "l0_norm_mix": gain(),
        "l0_fox_w_qkv": dense((D_MODEL, 3 * D_MODEL), D_MODEL),
        "l0_fox_w_f": dense((D_MODEL, N_HEADS), D_MODEL),
        "l0_fox_b_f": 4.0 + 0.5 * jax.random.normal(next(ks), (N_HEADS,), jnp.float32),
        "l0_fox_w_o": dense((D_MODEL, D_MODEL), D_MODEL),
        "l0_norm_mlp": gain(),
        "l0_mlp_w1": dense((D_MODEL, D_FF), D_MODEL),
        "l0_mlp_w2": dense((D_FF, D_MODEL), D_FF),
        "l1_norm_mix": gain(),
        "l1_pool_w": dense((len(POOL_WINDOWS), POOL_GROUP, POOL_GROUP), POOL_GROUP),
        "l1_pool_scale": 1.0 + 0.1 * jax.random.normal(next(ks), (D_MODEL,), jnp.float32),
        "l1_norm_mlp": gain(),
        "l1_mlp_w1": dense((D_MODEL, D_FF), D_MODEL),
        "l1_mlp_w2": dense((D_FF, D_MODEL), D_FF),
        "l2_norm_mix": gain(),
        "l2_conv_w_in": dense((D_MODEL, 3 * D_MODEL), D_MODEL),
        "l2_conv_w": dense((CONV_WIDTH, D_MODEL), CONV_WIDTH),
        "l2_conv_w_out": dense((D_MODEL, D_MODEL), D_MODEL),
        "l2_norm_mlp": gain(),
        "l2_mlp_w1": dense((D_MODEL, D_FF), D_MODEL),
        "l2_mlp_w2": dense((D_FF, D_MODEL), D_FF),
        "l3_norm_mix": gain(),
        "l3_nsa_w_in": dense((D_MODEL, nsa_in_width), D_MODEL),
        "l3_nsa_cmp_pe_k": 0.1 * jax.random.normal(next(ks), (CMP_BLOCK, HEAD_DIM), jnp.float32),
        "l3_nsa_cmp_w1_k": dense((CMP_BLOCK * HEAD_DIM, CMP_HIDDEN), CMP_BLOCK * HEAD_DIM),
        "l3_nsa_cmp_w2_k": dense((CMP_HIDDEN, HEAD_DIM), CMP_HIDDEN),
        "l3_nsa_cmp_pe_v": 0.1 * jax.random.normal(next(ks), (CMP_BLOCK, HEAD_DIM), jnp.float32),
        "l3_nsa_cmp_w1_v": dense((CMP_BLOCK * HEAD_DIM, CMP_HIDDEN), CMP_BLOCK * HEAD_DIM),
        "l3_nsa_cmp_w2_v": dense((CMP_HIDDEN, HEAD_DIM), CMP_HIDDEN),
        "l3_nsa_w_o": dense((N_HEADS * HEAD_DIM, D_MODEL), N_HEADS * HEAD_DIM),
        "l3_norm_mlp": gain(),
        "l3_mlp_w1": dense((D_MODEL, D_FF), D_MODEL),
        "l3_mlp_w2": dense((D_FF, D_MODEL), D_FF),
        "final_norm": gain(),
    }


def reference(x, positions,
              l0_norm_mix, l0_fox_w_qkv, l0_fox_w_f, l0_fox_b_f, l0_fox_w_o, l0_norm_mlp, l0_mlp_w1, l0_mlp_w2,
              l1_norm_mix, l1_pool_w, l1_pool_scale, l1_norm_mlp, l1_mlp_w1, l1_mlp_w2,
              l2_norm_mix, l2_conv_w_in, l2_conv_w, l2_conv_w_out, l2_norm_mlp, l2_mlp_w1, l2_mlp_w2,
              l3_norm_mix, l3_nsa_w_in, l3_nsa_cmp_pe_k, l3_nsa_cmp_w1_k, l3_nsa_cmp_w2_k,
              l3_nsa_cmp_pe_v, l3_nsa_cmp_w1_v, l3_nsa_cmp_w2_v, l3_nsa_w_o, l3_norm_mlp, l3_mlp_w1, l3_mlp_w2,
              final_norm):
    cos, sin = rope_tables(positions)
    mixers = (
        lambda t: fox_attention(t, l0_fox_w_qkv, l0_fox_w_f, l0_fox_b_f, l0_fox_w_o),
        lambda t: pool_mixer(t, l1_pool_w, l1_pool_scale),
        lambda t: short_conv_mixer(t, l2_conv_w_in, l2_conv_w, l2_conv_w_out),
        lambda t: nsa_attention(t, cos, sin, l3_nsa_w_in, l3_nsa_cmp_pe_k, l3_nsa_cmp_w1_k, l3_nsa_cmp_w2_k,
                                l3_nsa_cmp_pe_v, l3_nsa_cmp_w1_v, l3_nsa_cmp_w2_v, l3_nsa_w_o),
    )
    norm_mix = (l0_norm_mix, l1_norm_mix, l2_norm_mix, l3_norm_mix)
    norm_mlp = (l0_norm_mlp, l1_norm_mlp, l2_norm_mlp, l3_norm_mlp)
    mlp_w1 = (l0_mlp_w1, l1_mlp_w1, l2_mlp_w1, l3_mlp_w1)
    mlp_w2 = (l0_mlp_w2, l1_mlp_w2, l2_mlp_w2, l3_mlp_w2)
    h = x
    for i in range(DEPTH):
        h = h + mixers[i % N_MIXERS](rmsnorm(h, norm_mix[i]))
        h = h + sq_relu_mlp(rmsnorm(h, norm_mlp[i]), mlp_w1[i], mlp_w2[i])
    return rmsnorm(h, final_norm)
```

```cpp
#include <hip/hip_runtime.h>
#include <hip/hip_cooperative_groups.h>
#include <cstdio>
#include <cstdint>
namespace cg = cooperative_groups;

#define LAS __attribute__((address_space(3)))
typedef unsigned short bf16_t;
typedef short bf16x8 __attribute__((ext_vector_type(8)));
typedef short s16x4 __attribute__((ext_vector_type(4)));
typedef float f32x2 __attribute__((ext_vector_type(2)));
typedef float f32x4 __attribute__((ext_vector_type(4)));
typedef float f32x16 __attribute__((ext_vector_type(16)));
typedef unsigned u32x2 __attribute__((ext_vector_type(2)));
typedef unsigned u32x4 __attribute__((ext_vector_type(4)));
typedef LAS unsigned char* ldsp;

constexpr int S = 16384, D = 1024, FF = 4096, NH = 16, HD = 64;
constexpr int NQKV_PAD = 3328;
constexpr int NSA_W = 2608, NSA_PAD = 2816;
constexpr int NCMP = 1023;
constexpr float RMS_EPS = 1e-6f;
constexpr float NEGF = -1e30f;
constexpr float LOG2E = 1.4426950408889634f;
constexpr float C2 = 0.125f * 1.4426950408889634f;

constexpr size_t MiB = 1u << 20;
constexpr size_t WS_HID = 0;
constexpr size_t WS_XN = 128 * MiB;
constexpr size_t WS_W1T = 160 * MiB;
constexpr size_t WS_W2T = 168 * MiB;
constexpr size_t WS_WMIX = 176 * MiB;
constexpr size_t WS_MISC = 190 * MiB;
constexpr size_t WS_END = 256 * MiB;
constexpr size_t WS_FQ = 0, WS_FK = 32 * MiB, WS_FV = 64 * MiB, WS_FO = 96 * MiB;
constexpr size_t WS_LF = WS_MISC;
constexpr size_t WS_KMAX = WS_MISC + 2 * MiB;
constexpr size_t WS_PD = 0;
constexpr size_t WS_BCU = 0;
constexpr size_t WS_CY = 96 * MiB;
constexpr size_t WS_NQ = 0;
constexpr size_t WS_O3 = 32 * MiB;
constexpr size_t NSA_KV_STRIDE = 9 * MiB;
constexpr size_t WS_KCR = 190 * MiB, WS_VCR = 199 * MiB, WS_KSL = 208 * MiB, WS_VST = 217 * MiB, WS_KWN = 226 * MiB, WS_VWN = 235 * MiB;
constexpr size_t WS_GAT = 244 * MiB;
constexpr size_t WS_CH = 247 * MiB;
constexpr size_t WS_KC = 255 * MiB;
constexpr size_t WS_VC = 255 * MiB + 512 * 1024;
constexpr size_t WS_COS = 198 * MiB + 64 * 1024;
constexpr size_t WS_SIN = 207 * MiB + 64 * 1024;
constexpr size_t WS_BAR = 198 * MiB + 16 * 1024;
constexpr size_t WS_CB = 216 * MiB + 64 * 1024;
constexpr size_t WM_A = 0;
constexpr size_t WM_B = 7 * MiB;
constexpr size_t WM_C = 13 * MiB;
constexpr size_t WM_NSA_IN = 0, WM_NSA_WO = 6 * MiB, WM_NSA_C1K = 12 * MiB, WM_NSA_C1V = 13 * MiB, WM_NSA_C2K = 5 * MiB + 512 * 1024, WM_NSA_C2V = 5 * MiB + 768 * 1024;

constexpr int LDS_BYTES = 147456;
constexpr int ATT_BUF = 0;
constexpr int ATT_WSF = 32768;
constexpr int ATT_OST = 34816;
constexpr int ATT_BIG = 67584;
constexpr int ATT_SEL = 133120;
constexpr int ATT_MISC = 137216;
constexpr int LDS_XB = 147392;

typedef __bf16 bf16x2_t __attribute__((ext_vector_type(2)));
__device__ __forceinline__ unsigned pk2(float lo, float hi) { const f32x2 v = {lo, hi}; const bf16x2_t b = __builtin_convertvector(v, bf16x2_t); return __builtin_bit_cast(unsigned, b); }
__device__ __forceinline__ unsigned f2bf(float f) { return pk2(f, 0.f) & 0xffffu; }
__device__ __forceinline__ float bf2f(unsigned short b) { return __builtin_bit_cast(float, (unsigned)b << 16); }
__device__ __forceinline__ float wave_sum(float v) {
#pragma unroll
    for (int o = 1; o < 64; o <<= 1) v += __shfl_xor(v, o);
    return v;
}
__device__ __forceinline__ int fresh_tid() { int t = threadIdx.x; asm volatile("" : "+v"(t)); return t; }
__device__ __forceinline__ float ex2(float x) { return __builtin_amdgcn_exp2f(x); }
__device__ __forceinline__ long pk8_fp8(float a0, float a1, float a2, float a3, float a4, float a5, float a6, float a7) {
    int w0 = __builtin_amdgcn_cvt_pk_fp8_f32(a0, a1, 0, false); w0 = __builtin_amdgcn_cvt_pk_fp8_f32(a2, a3, w0, true);
    int w1 = __builtin_amdgcn_cvt_pk_fp8_f32(a4, a5, 0, false); w1 = __builtin_amdgcn_cvt_pk_fp8_f32(a6, a7, w1, true);
    return (long)(((unsigned long long)(unsigned)w1 << 32) | (unsigned long long)(unsigned)w0);
}
__device__ __forceinline__ float xmax16(float x) { const unsigned b = __builtin_bit_cast(unsigned, x); auto r = __builtin_amdgcn_permlane16_swap(b, b, false, false); return fmaxf(__builtin_bit_cast(float, r[0]), __builtin_bit_cast(float, r[1])); }
__device__ __forceinline__ float xmax32(float x) { const unsigned b = __builtin_bit_cast(unsigned, x); auto r = __builtin_amdgcn_permlane32_swap(b, b, false, false); return fmaxf(__builtin_bit_cast(float, r[0]), __builtin_bit_cast(float, r[1])); }
__device__ __forceinline__ float dpp_xor1(float v) { return __builtin_bit_cast(float, __builtin_amdgcn_update_dpp(0, __builtin_bit_cast(int, v), 0xB1, 0xF, 0xF, true)); }
__device__ __forceinline__ float dpp_xor2(float v) { return __builtin_bit_cast(float, __builtin_amdgcn_update_dpp(0, __builtin_bit_cast(int, v), 0x4E, 0xF, 0xF, true)); }
__device__ __forceinline__ int crow(int r, int hi) { return (r & 3) + 8 * (r >> 2) + 4 * hi; }

namespace pg8 {
constexpr int BM = 256, BK = 64, HALF = 128, HTB = HALF * BK * 2, STAGE_BYTES = 8 * HTB, NXCD = 8, WGM = 4;
__device__ __forceinline__ int lds_byte(int r, int c) { const int st = (r >> 4) * 2 + (c >> 5), rr = r & 15, cc = c & 31, ob = rr * 64 + cc * 2; return st * 1024 + (ob ^ (((ob >> 9) & 1) << 5)); }
__device__ __forceinline__ void stage_rc(int b, int& R, int& C) { const int st = b / 1024, sb = b % 1024, swz = sb ^ (((sb >> 9) & 1) << 5); R = (st >> 1) * 16 + swz / 64; C = (st & 1) * 32 + (swz % 64) / 2; }
__device__ __forceinline__ int perm32(int rho) { const int n = rho >> 4, i = rho & 15; return 8 * (i >> 2) + 4 * n + (i & 3); }

struct Unit { int pm, pn; };
struct Gemm { const bf16_t* A; const bf16_t* Bt; int M, N, K; int lda; size_t a_pn_bytes; };

struct StaticOrder {
    int nM, nN, nwg, G, c;
    __device__ void init(int M, int N, int G_, int c_) { nM = M / BM; nN = N / BM; nwg = nM * nN; G = G_; c = c_; }
    __device__ bool next(int i, Unit& u) const {
        const long L = (long)i * G + c; if (L >= nwg) return false;
        int wgid = (int)L; { const int q = nwg / NXCD, r = nwg % NXCD, xcd = wgid % NXCD, off = wgid / NXCD; wgid = (xcd < r ? xcd * (q + 1) : r * (q + 1) + (xcd - r) * q) + off; }
        const int nig = WGM * nN, gid = wgid / nig, fm = gid * WGM, gsz = (nM - fm) < WGM ? (nM - fm) : WGM;
        u.pm = fm + ((wgid % nig) % gsz); u.pn = (wgid % nig) / gsz; return true;
    }
};

template <class Epi, bool ALIGN_EPI>
__device__ __forceinline__ void gemm_phase(ldsp lds, const Gemm g, const StaticOrder& S, const Epi& E) {
    int tid = threadIdx.x; asm volatile("" : "+v"(tid));
    const int wid = __builtin_amdgcn_readfirstlane(tid >> 6), lane = tid & 63, wr = wid >> 2, wc = wid & 3, fr = lane & 15, fq = lane >> 4;
    const int K = g.K, nt = K / BK;
    unsigned voffA[2], voffB[2];
#pragma unroll
    for (int i = 0; i < 2; ++i) { int R, C; stage_rc(tid * 16 + i * 8192, R, C); const int Rb = Epi::PERM ? ((R & ~31) + perm32(R & 31)) : R;
        voffA[i] = (unsigned)(R * g.lda + C) * 2u; voffB[i] = (unsigned)(Rb * K + C) * 2u; }
    const size_t kstep = (size_t)(BK * 2);
    const size_t hstepA = (size_t)HALF * g.lda * 2, hstepB = (size_t)HALF * K * 2;
    const size_t tstepA = 2 * hstepA, tstepB = 2 * hstepB;
    const unsigned ldsw = (unsigned)wid * 1024u;
    const int aoff = lds_byte(wr * 64 + fr, fq * 8), boff = lds_byte(wc * 32 + fr, fq * 8);
#define PG8_SA(b, h) (((b) * 2 + (h)) * HTB)
#define PG8_SB(b, h) ((4 + (b) * 2 + (h)) * HTB)
#define PG8_STAGE(bufoff, gbase, voff) do { _Pragma("unroll") for (int _i = 0; _i < 2; ++_i) \
        __builtin_amdgcn_global_load_lds((const unsigned*)((const char*)(gbase) + (voff)[_i]), (LAS unsigned*)(lds + (bufoff) + ldsw + _i * 8192), 16, 0, 0); } while (0)
#define PG8_LDA(dst, b, h) do { _Pragma("unroll") for (int m = 0; m < 4; ++m) _Pragma("unroll") for (int k = 0; k < 2; ++k) dst[m][k] = *(const LAS bf16x8*)(lds + PG8_SA(b, h) + aoff + m * 2048 + k * 1024); } while (0)
#define PG8_LDB(dst, b, h) do { _Pragma("unroll") for (int n = 0; n < 2; ++n) _Pragma("unroll") for (int k = 0; k < 2; ++k) dst[n][k] = *(const LAS bf16x8*)(lds + PG8_SB(b, h) + boff + n * 2048 + k * 1024); } while (0)
#define PG8_MMA(ai, bj, At, Bt) do { __builtin_amdgcn_s_setprio(1); _Pragma("unroll") for (int m = 0; m < 4; ++m) _Pragma("unroll") for (int n = 0; n < 2; ++n) _Pragma("unroll") for (int k = 0; k < 2; ++k) \
        acc[ai][bj][m][n] = __builtin_amdgcn_mfma_f32_16x16x32_bf16(Bt[n][k], At[m][k], acc[ai][bj][m][n], 0, 0, 0); __builtin_amdgcn_s_setprio(0); } while (0)
#define PG8_WAIT_V(n) asm volatile("s_waitcnt vmcnt(" #n ")" ::: "memory")
#define PG8_WAIT_L(n) asm volatile("s_waitcnt lgkmcnt(" #n ")" ::: "memory")
#define PG8_BAR __builtin_amdgcn_s_barrier()
#define PG8_SCHED __builtin_amdgcn_sched_barrier(0)
    Unit cur, nxt; int ui = 0;
    if (!S.next(0, cur)) return;
    f32x4 acc[2][2][4][2];
#pragma unroll
    for (int a = 0; a < 2; ++a)
#pragma unroll
        for (int b = 0; b < 2; ++b)
#pragma unroll
            for (int m = 0; m < 4; ++m)
#pragma unroll
                for (int n = 0; n < 2; ++n) acc[a][b][m][n] = (f32x4){0.f, 0.f, 0.f, 0.f};
    bf16x8 At[4][2], B0[2][2], B1[2][2];
    const char* cA = (const char*)g.A + (size_t)cur.pm * tstepA + (size_t)cur.pn * g.a_pn_bytes; const char* cB = (const char*)g.Bt + (size_t)cur.pn * tstepB;
    PG8_STAGE(PG8_SB(0, 0), cB, voffB); PG8_STAGE(PG8_SB(0, 1), cB + hstepB, voffB); PG8_STAGE(PG8_SA(0, 0), cA, voffA); PG8_STAGE(PG8_SA(0, 1), cA + hstepA, voffA);
    if (wr == 1) PG8_BAR;
    PG8_WAIT_V(2); PG8_BAR;
    PG8_STAGE(PG8_SB(1, 0), cB + kstep, voffB); PG8_STAGE(PG8_SA(1, 0), cA + kstep, voffA); PG8_STAGE(PG8_SB(1, 1), cB + hstepB + kstep, voffB);
    PG8_WAIT_V(6); PG8_BAR;
    for (;;) {
        const bool has_next = S.next(ui + 1, nxt);
        const char* nA = has_next ? (const char*)g.A + (size_t)nxt.pm * tstepA + (size_t)nxt.pn * g.a_pn_bytes : cA; const char* nB = has_next ? (const char*)g.Bt + (size_t)nxt.pn * tstepB : cB;
        for (int t = 0; t < nt; t += 2) {
            const bool last = (t == nt - 2);
            const char* a1 = cA + (size_t)(t + 1) * kstep;
            const char* a2 = last ? nA : cA + (size_t)(t + 2) * kstep; const char* b2 = last ? nB : cB + (size_t)(t + 2) * kstep;
            const char* a3 = a2 + kstep; const char* b3 = b2 + kstep;
            PG8_LDB(B0, 0, 0); PG8_LDB(B1, 0, 1); PG8_SCHED; PG8_LDA(At, 0, 0); PG8_STAGE(PG8_SA(1, 1), a1 + hstepA, voffA);
            PG8_WAIT_V(8); PG8_WAIT_L(0); PG8_BAR; PG8_MMA(0, 0, At, B0); PG8_MMA(0, 1, At, B1); PG8_BAR; PG8_SCHED;
            PG8_LDA(At, 0, 1); PG8_STAGE(PG8_SB(0, 0), b2, voffB); PG8_STAGE(PG8_SB(0, 1), b2 + hstepB, voffB); PG8_STAGE(PG8_SA(0, 0), a2, voffA);
            PG8_WAIT_V(8); PG8_WAIT_L(0); PG8_BAR; PG8_MMA(1, 0, At, B0); PG8_MMA(1, 1, At, B1); PG8_BAR; PG8_SCHED;
            PG8_LDB(B0, 1, 0); PG8_LDB(B1, 1, 1); PG8_SCHED; PG8_LDA(At, 1, 0); PG8_STAGE(PG8_SA(0, 1), a2 + hstepA, voffA);
            PG8_WAIT_V(8); PG8_WAIT_L(0); PG8_BAR; PG8_MMA(0, 0, At, B0); PG8_MMA(0, 1, At, B1); PG8_BAR; PG8_SCHED;
            PG8_LDA(At, 1, 1); PG8_STAGE(PG8_SB(1, 0), b3, voffB); PG8_STAGE(PG8_SB(1, 1), b3 + hstepB, voffB); PG8_STAGE(PG8_SA(1, 0), a3, voffA);
            PG8_WAIT_V(8); PG8_WAIT_L(0); PG8_BAR; PG8_MMA(1, 0, At, B0); PG8_MMA(1, 1, At, B1); PG8_BAR; PG8_SCHED;
        }
        if constexpr (ALIGN_EPI) { if (wr == 0) PG8_BAR; }
        E(acc, cur, wr, wc, fr, fq);
        if (!has_next) break;
#pragma unroll
        for (int a = 0; a < 2; ++a)
#pragma unroll
            for (int b = 0; b < 2; ++b)
#pragma unroll
                for (int m = 0; m < 4; ++m)
#pragma unroll
                    for (int n = 0; n < 2; ++n) acc[a][b][m][n] = (f32x4){0.f, 0.f, 0.f, 0.f};
        cur = nxt; cA = nA; cB = nB; ++ui;
        if constexpr (ALIGN_EPI) { if (wr == 1) PG8_BAR; }
    }
    PG8_WAIT_V(0);
    if constexpr (!ALIGN_EPI) { if (wr == 0) PG8_BAR; }
    PG8_BAR;
#undef PG8_SA
#undef PG8_SB
#undef PG8_STAGE
#undef PG8_LDA
#undef PG8_LDB
#undef PG8_MMA
#undef PG8_WAIT_V
#undef PG8_WAIT_L
#undef PG8_BAR
#undef PG8_SCHED
}

typedef f32x4 Acc[2][2][4][2];

template <int ACT  > struct EpiBf16 {
    static constexpr bool PERM = true;
    bf16_t* O; int ldc;
    __device__ __forceinline__ void operator()(const Acc& acc, const Unit& u, int wr, int wc, int fr, int fq) const {
        const int row0 = u.pm * BM + wr * 64 + fr, col0 = u.pn * BM + wc * 32 + 8 * fq;
#pragma unroll
        for (int ai = 0; ai < 2; ++ai)
#pragma unroll
            for (int m = 0; m < 4; ++m) { bf16_t* rowp = O + (size_t)(row0 + ai * HALF + m * 16) * ldc + col0;
#pragma unroll
                for (int bj = 0; bj < 2; ++bj) { f32x4 v0 = acc[ai][bj][m][0], v1 = acc[ai][bj][m][1];
                    if (ACT == 1) {
#pragma unroll
                        for (int e = 0; e < 4; ++e) { float a = fmaxf(v0[e], 0.f), b = fmaxf(v1[e], 0.f); v0[e] = a * a; v1[e] = b * b; } }
                    u32x4 w; w.x = pk2(v0[0], v0[1]); w.y = pk2(v0[2], v0[3]); w.z = pk2(v1[0], v1[1]); w.w = pk2(v1[2], v1[3]);
                    *(u32x4*)(rowp + bj * HALF) = w; } }
    }
};

struct EpiRes {
    static constexpr bool PERM = false;
    const float* base; float* out; const float* cs;
    __device__ __forceinline__ void operator()(const Acc& acc, const Unit& u, int wr, int wc, int fr, int fq) const {
        const int col0 = u.pn * BM + wc * 32 + 4 * fq;
        f32x4 csv[2][2];
#pragma unroll
        for (int bj = 0; bj < 2; ++bj)
#pragma unroll
            for (int n = 0; n < 2; ++n) csv[bj][n] = cs ? *(const f32x4*)(cs + col0 + bj * HALF + n * 16) : (f32x4){1.f, 1.f, 1.f, 1.f};
#pragma unroll
        for (int ai = 0; ai < 2; ++ai) {
            f32x4 pre[4][2][2];
#pragma unroll
            for (int m = 0; m < 4; ++m) { const size_t off = (size_t)(u.pm * BM + ai * HALF + wr * 64 + m * 16 + fr) * D + col0;
#pragma unroll
                for (int bj = 0; bj < 2; ++bj)
#pragma unroll
                    for (int n = 0; n < 2; ++n) pre[m][bj][n] = *(const f32x4*)(base + off + bj * HALF + n * 16); }
#pragma unroll
            for (int m = 0; m < 4; ++m) { const size_t off = (size_t)(u.pm * BM + ai * HALF + wr * 64 + m * 16 + fr) * D + col0;
#pragma unroll
                for (int bj = 0; bj < 2; ++bj)
#pragma unroll
                    for (int n = 0; n < 2; ++n) *(f32x4*)(out + off + bj * HALF + n * 16) = pre[m][bj][n] + acc[ai][bj][m][n] * csv[bj][n]; }
        }
    }
};

__device__ __forceinline__ float logsigmoid(float x) { return fminf(x, 0.f) - log1pf(expf(-fabsf(x))); }

struct EpiQKV {
    static constexpr bool PERM = true;
    bf16_t* Q; bf16_t* Kb; bf16_t* Vb; float* lf; const float* bfg; unsigned* kmax;
    __device__ __forceinline__ void operator()(const Acc& acc, const Unit& u, int wr, int wc, int fr, int fq) const {
        const int row0 = u.pm * BM + wr * 64 + fr;
        if (u.pn >= 4 && u.pn < 8) {
            float mx[2] = {0.f, 0.f};
#pragma unroll
            for (int ai = 0; ai < 2; ++ai)
#pragma unroll
                for (int m = 0; m < 4; ++m)
#pragma unroll
                    for (int bj = 0; bj < 2; ++bj) { const f32x4 v0 = acc[ai][bj][m][0], v1 = acc[ai][bj][m][1];
                        float s2 = (v0[0] * v0[0] + v0[1] * v0[1]) + (v0[2] * v0[2] + v0[3] * v0[3]) + (v1[0] * v1[0] + v1[1] * v1[1]) + (v1[2] * v1[2] + v1[3] * v1[3]);
                        s2 += __shfl_xor(s2, 16); s2 += __shfl_xor(s2, 32); mx[bj] = fmaxf(mx[bj], s2); }
#pragma unroll
            for (int bj = 0; bj < 2; ++bj) { float v = mx[bj];
#pragma unroll
                for (int o = 1; o < 16; o <<= 1) v = fmaxf(v, __shfl_xor(v, o));
                if ((threadIdx.x & 63) == 0) atomicMax(kmax + (((u.pn - 4) * 4 + bj * 2 + (wc >> 1)) * 2 + (wc & 1)), __builtin_bit_cast(unsigned, v * 1.02f)); }
        }
        if (u.pn < 12) {
            const int t = u.pn >> 2; bf16_t* base = Q + (size_t)t * ((size_t)S * D); const float sc = t == 0 ? C2 : 1.f;
            const int col0 = (u.pn & 3) * BM + wc * 32 + 8 * fq;
#pragma unroll
            for (int ai = 0; ai < 2; ++ai)
#pragma unroll
                for (int m = 0; m < 4; ++m) { bf16_t* rowp = base + (size_t)(row0 + ai * HALF + m * 16) * D + col0;
#pragma unroll
                    for (int bj = 0; bj < 2; ++bj) { const f32x4 v0 = acc[ai][bj][m][0] * sc, v1 = acc[ai][bj][m][1] * sc;
                        u32x4 w; w.x = pk2(v0[0], v0[1]); w.y = pk2(v0[2], v0[3]); w.z = pk2(v1[0], v1[1]); w.w = pk2(v1[2], v1[3]);
                        *(u32x4*)(rowp + bj * HALF) = w; } }
        } else if (wc == 0 && fq < 2) {
#pragma unroll
            for (int ai = 0; ai < 2; ++ai)
#pragma unroll
                for (int m = 0; m < 4; ++m) { const int row = row0 + ai * HALF + m * 16;
#pragma unroll
                    for (int n = 0; n < 2; ++n)
#pragma unroll
                        for (int e = 0; e < 4; ++e) { const int head = 8 * fq + 4 * n + e; lf[(size_t)head * S + row] = logsigmoid(acc[ai][0][m][n][e] + bfg[head]); } }
        }
    }
};

struct EpiNSA {
    static constexpr bool PERM = true;
    bf16_t* Q; bf16_t* kcr; bf16_t* vcr; bf16_t* ksl; bf16_t* vst; bf16_t* kwn; bf16_t* vwn; float* gates; const float* cosT; const float* sinT;
    __device__ __forceinline__ void operator()(const Acc& acc, const Unit& u, int wr, int wc, int fr, int fq) const {
        const int row0 = u.pm * BM + wr * 64 + fr; const int pn = u.pn;
        if (pn == 10) {
            if (wc < 2) {
#pragma unroll
                for (int ai = 0; ai < 2; ++ai)
#pragma unroll
                    for (int m = 0; m < 4; ++m) { const int row = row0 + ai * HALF + m * 16; const int c0 = wc * 32 + 8 * fq;
                        if (c0 < 48) {
#pragma unroll
                            for (int n = 0; n < 2; ++n) { f32x4 v = acc[ai][0][m][n];
#pragma unroll
                                for (int e = 0; e < 4; ++e) v[e] = 1.f / (1.f + expf(-v[e]));
                                *(f32x4*)(gates + (size_t)row * 48 + c0 + 4 * n) = v; } } }
            }
            return;
        }
        const bool do_rope = (pn < 4 || pn == 6 || pn == 8) && ((wc & 1) == 0);
        const float sc = pn < 4 ? C2 : 1.f;
#pragma unroll
        for (int ai = 0; ai < 2; ++ai)
#pragma unroll
            for (int m = 0; m < 4; ++m) { const int row = row0 + ai * HALF + m * 16;
                f32x4 cs0 = {1.f, 1.f, 1.f, 1.f}, cs1 = cs0, sn0 = {0.f, 0.f, 0.f, 0.f}, sn1 = sn0;
                if (do_rope) { cs0 = *(const f32x4*)(cosT + (size_t)row * 8); cs1 = *(const f32x4*)(cosT + (size_t)row * 8 + 4); sn0 = *(const f32x4*)(sinT + (size_t)row * 8); sn1 = *(const f32x4*)(sinT + (size_t)row * 8 + 4); }
#pragma unroll
                for (int bj = 0; bj < 2; ++bj) { f32x4 v0 = acc[ai][bj][m][0], v1 = acc[ai][bj][m][1];
                    if (do_rope) { f32x4 p0, p1;
#pragma unroll
                        for (int e = 0; e < 4; ++e) { p0[e] = __shfl_xor(v0[e], 16); p1[e] = __shfl_xor(v1[e], 16); }
                        if (fq == 0) { v0 = v0 * cs0 - p0 * sn0; v1 = v1 * cs1 - p1 * sn1; }
                        else if (fq == 1) { v0 = v0 * cs0 + p0 * sn0; v1 = v1 * cs1 + p1 * sn1; } }
                    v0 = v0 * sc; v1 = v1 * sc;
                    const int cl = bj * HALF + wc * 32 + 8 * fq;
                    if (pn < 4) { u32x4 w; w.x = pk2(v0[0], v0[1]); w.y = pk2(v0[2], v0[3]); w.z = pk2(v1[0], v1[1]); w.w = pk2(v1[2], v1[3]);
                        *(u32x4*)(Q + (size_t)row * D + pn * BM + cl) = w; }
                    else if (pn == 6) { const int kvh = cl >> 6, d0 = cl & 63;
                        *(long*)((unsigned char*)ksl + ((size_t)kvh * S + row) * 64 + d0) = pk8_fp8(v0[0], v0[1], v0[2], v0[3], v1[0], v1[1], v1[2], v1[3]); }
                    else if (pn == 7) { const int kvh = cl >> 6, d0 = cl & 63; const int blk = row >> 6, kk = row & 63;
                        const int g4 = kk >> 4, mgk = (kk >> 2) & 3, rr = kk & 3; const int slot = 16 * mgk + 8 * (g4 >> 1) + 4 * (g4 & 1) + rr;
                        unsigned char* dst = (unsigned char*)vst + ((size_t)(kvh * 256 + blk) * 64 + d0) * 64 + slot;
                        const long pk = pk8_fp8(v0[0], v0[1], v0[2], v0[3], v1[0], v1[1], v1[2], v1[3]);
#pragma unroll
                        for (int e = 0; e < 8; ++e) dst[(size_t)e * 64] = (unsigned char)((unsigned long long)pk >> (8 * e)); }
                    else { bf16_t* base = (bf16_t*)((unsigned char*)kcr + (size_t)(pn - 4) * NSA_KV_STRIDE);
                        const int kvh = cl >> 6, d0 = cl & 63;
                        u32x4 w; w.x = pk2(v0[0], v0[1]); w.y = pk2(v0[2], v0[3]); w.z = pk2(v1[0], v1[1]); w.w = pk2(v1[2], v1[3]);
                        *(u32x4*)(base + ((size_t)kvh * S + row) * 64 + d0) = w; } } }
    }
};

struct EpiCmp {
    static constexpr bool PERM = false;
    bf16_t* O; const float* bias;
    __device__ __forceinline__ void operator()(const Acc& acc, const Unit& u, int wr, int wc, int fr, int fq) const {
        const int col0 = u.pn * BM + wc * 32 + 4 * fq;
#pragma unroll
        for (int ai = 0; ai < 2; ++ai)
#pragma unroll
            for (int m = 0; m < 4; ++m) { const size_t off = (size_t)(u.pm * BM + ai * HALF + wr * 64 + m * 16 + fr) * 256 + col0;
#pragma unroll
                for (int bj = 0; bj < 2; ++bj)
#pragma unroll
                    for (int n = 0; n < 2; ++n) { const int o2 = bj * HALF + n * 16; f32x4 a = acc[ai][bj][m][n] + *(const f32x4*)(bias + col0 + o2);
#pragma unroll
                        for (int e = 0; e < 4; ++e) { const float x = a[e]; a[e] = 0.5f * x * (1.f + tanhf(0.7978845608028654f * (x + 0.044715f * x * x * x))); }
                        u32x2 w; w.x = pk2(a[0], a[1]); w.y = pk2(a[2], a[3]); *(u32x2*)(O + off + o2) = w; } }
    }
};
template <bool ROPE> struct EpiCmp2 {
    static constexpr bool PERM = false;
    bf16_t* O; const float* cosT; const float* sinT;
    __device__ __forceinline__ void operator()(const Acc& acc, const Unit& u, int wr, int wc, int fr, int fq) const {
        if (wc >= 2) return;
#pragma unroll
        for (int ai = 0; ai < 2; ++ai)
#pragma unroll
            for (int m = 0; m < 4; ++m) { const int row = u.pm * BM + ai * HALF + wr * 64 + m * 16 + fr; const int nr = row & 1023;
#pragma unroll
                for (int n = 0; n < 2; ++n) { f32x4 v = acc[ai][0][m][n];
                    if (ROPE && n == 0 && wc == 0) { const int pe_ = 16 * nr + 31; const int pidx = pe_ < S ? pe_ : S - 1;
                        const f32x4 c = *(const f32x4*)(cosT + (size_t)pidx * 8 + 4 * (fq & 1)), sn = *(const f32x4*)(sinT + (size_t)pidx * 8 + 4 * (fq & 1)); f32x4 p;
#pragma unroll
                        for (int e = 0; e < 4; ++e) p[e] = __shfl_xor(v[e], 32);
                        v = fq < 2 ? v * c - p * sn : v * c + p * sn; }
                    if (nr >= NCMP) v = (f32x4){0.f, 0.f, 0.f, 0.f};
                    u32x2 w; w.x = pk2(v[0], v[1]); w.y = pk2(v[2], v[3]); *(u32x2*)(O + (size_t)row * 64 + wc * 32 + n * 16 + 4 * fq) = w; } }
    }
};
}

template <int FIRST_BLK = 0>
__device__ __forceinline__ void cvt_mat(const float* W, int K, int N, int Npad, bf16_t* WT, int ldk, int row_off, int col_off, LAS float* scr, int gw_unused, int NGW, int lane_unused) {
    if (FIRST_BLK > 0 && (int)blockIdx.x < FIRST_BLK) return;
    const int ftid = fresh_tid(); const int lane = ftid & 63, wv = __builtin_amdgcn_readfirstlane(ftid >> 6); const int gw = ((int)blockIdx.x - FIRST_BLK) * 8 + wv;
    const int nblk = Npad / 32, nitems = (K / 64) * nblk;
    for (int item = gw; item < nitems; item += NGW) {
        const int kb = item / nblk, nb = item % nblk, k0 = 64 * kb, n0 = 32 * nb;
        const int q4 = lane & 7, nn = n0 + 4 * q4;
        f32x4 wv[8];
#pragma unroll
        for (int i = 0; i < 8; ++i) { const int kk = 8 * i + (lane >> 3); wv[i] = (nn < N) ? *(const f32x4*)(W + (size_t)(k0 + kk) * N + nn) : (f32x4){0.f, 0.f, 0.f, 0.f}; }
#pragma unroll
        for (int i = 0; i < 8; ++i) { const int kk = 8 * i + (lane >> 3);
#pragma unroll
            for (int e = 0; e < 4; ++e) scr[kk * 33 + 4 * q4 + e] = wv[i][e]; }
        asm volatile("s_waitcnt lgkmcnt(0)" ::: "memory");
        const int c = lane & 7;
#pragma unroll
        for (int j = 0; j < 4; ++j) { const int n = (lane >> 3) + 8 * j; const LAS float* s = scr + (8 * c) * 33 + n;
            u32x4 o; o.x = pk2(s[0 * 33], s[1 * 33]); o.y = pk2(s[2 * 33], s[3 * 33]); o.z = pk2(s[4 * 33], s[5 * 33]); o.w = pk2(s[6 * 33], s[7 * 33]);
            *(u32x4*)(WT + (size_t)(row_off + n0 + n) * ldk + col_off + k0 + 8 * c) = o; }
        asm volatile("s_waitcnt lgkmcnt(0)" ::: "memory");
    }
}

__device__ __forceinline__ void norm_phase(const float* h, const float* gain, bf16_t* xn, int gw_unused, int NGW, int lane_unused) {
    const int ftid = fresh_tid(); const int lane = ftid & 63; const int gw = blockIdx.x * 8 + __builtin_amdgcn_readfirstlane(ftid >> 6);
    f32x4 g[4];
#pragma unroll
    for (int j = 0; j < 4; ++j) g[j] = ((const f32x4*)gain)[lane + 64 * j];
    f32x4 vn[4];
    if (gw < S) {
#pragma unroll
        for (int j = 0; j < 4; ++j) vn[j] = ((const f32x4*)(h + (size_t)gw * D) + lane)[64 * j]; }
    for (int m = gw; m < S; m += NGW) {
        f32x4 v[4]; float s = 0.f;
#pragma unroll
        for (int j = 0; j < 4; ++j) { v[j] = vn[j]; s += (v[j].x * v[j].x + v[j].y * v[j].y) + (v[j].z * v[j].z + v[j].w * v[j].w); }
        if (m + NGW < S) {
#pragma unroll
            for (int j = 0; j < 4; ++j) vn[j] = ((const f32x4*)(h + (size_t)(m + NGW) * D) + lane)[64 * j]; }
        const float r = rsqrtf(wave_sum(s) * (1.f / D) + RMS_EPS);
        u32x2* o8 = (u32x2*)(xn + (size_t)m * D) + lane;
#pragma unroll
        for (int j = 0; j < 4; ++j) { const f32x4 y = v[j] * r * g[j]; u32x2 w; w.x = pk2(y.x, y.y); w.y = pk2(y.z, y.w); o8[64 * j] = w; }
    }
}
__device__ __forceinline__ void final_norm_phase(float* h, const float* gain, int gw_unused, int NGW, int lane_unused) {
    const int ftid = fresh_tid(); const int lane = ftid & 63; const int gw = blockIdx.x * 8 + __builtin_amdgcn_readfirstlane(ftid >> 6);
    f32x4 g[4];
#pragma unroll
    for (int j = 0; j < 4; ++j) g[j] = ((const f32x4*)gain)[lane + 64 * j];
    f32x4 vn[4];
    if (gw < S) {
#pragma unroll
        for (int j = 0; j < 4; ++j) vn[j] = ((const f32x4*)(h + (size_t)gw * D) + lane)[64 * j]; }
    for (int m = gw; m < S; m += NGW) {
        f32x4* xr = (f32x4*)(h + (size_t)m * D) + lane; f32x4 v[4]; float s = 0.f;
#pragma unroll
        for (int j = 0; j < 4; ++j) { v[j] = vn[j]; s += (v[j].x * v[j].x + v[j].y * v[j].y) + (v[j].z * v[j].z + v[j].w * v[j].w); }
        if (m + NGW < S) {
#pragma unroll
            for (int j = 0; j < 4; ++j) vn[j] = ((const f32x4*)(h + (size_t)(m + NGW) * D) + lane)[64 * j]; }
        const float r = rsqrtf(wave_sum(s) * (1.f / D) + RMS_EPS);
#pragma unroll
        for (int j = 0; j < 4; ++j) xr[64 * j] = v[j] * r * g[j];
    }
}

__device__ __forceinline__ void unpack8(const u32x4 w, float* f) {
    f[0] = __builtin_bit_cast(float, w.x << 16); f[1] = __builtin_bit_cast(float, w.x & 0xffff0000u);
    f[2] = __builtin_bit_cast(float, w.y << 16); f[3] = __builtin_bit_cast(float, w.y & 0xffff0000u);
    f[4] = __builtin_bit_cast(float, w.z << 16); f[5] = __builtin_bit_cast(float, w.z & 0xffff0000u);
    f[6] = __builtin_bit_cast(float, w.w << 16); f[7] = __builtin_bit_cast(float, w.w & 0xffff0000u);
}

template <int W> __device__ __forceinline__ void pool_item(const bf16_t* xn, bf16_t* pd, int t, int ch, int g) {
    float a[8] = {0.f, 0.f, 0.f, 0.f, 0.f, 0.f, 0.f, 0.f}, x0[8];
    u32x4 v[W];
#pragma unroll
    for (int i = 0; i < W; ++i) { const int tt = t - i >= 0 ? t - i : 0; v[i] = *(const u32x4*)(xn + (size_t)tt * D + ch * 8); }
    unpack8(v[0], x0);
#pragma unroll
    for (int i = 0; i < W; ++i) { float x[8]; unpack8(v[i], x); const float k = (t - i >= 0) ? 1.f : 0.f;
#pragma unroll
        for (int e = 0; e < 8; ++e) a[e] += k * x[e]; }
    const int cnt = t + 1 < W ? t + 1 : W; const float inv = 1.f / (float)cnt;
#pragma unroll
    for (int e = 0; e < 8; ++e) a[e] = a[e] * inv - x0[e];
    u32x4 o; o.x = pk2(a[0], a[1]); o.y = pk2(a[2], a[3]); o.z = pk2(a[4], a[5]); o.w = pk2(a[6], a[7]);
    *(u32x4*)(pd + ((size_t)g * S + t) * 256 + (ch & 31) * 8) = o;
}
__device__ __forceinline__ void pool_diff_phase(const bf16_t* xn, bf16_t* pd, int gtid_unused, int NT) {
    const int gtid = blockIdx.x * 512 + fresh_tid();
#pragma unroll 2
    for (int it = gtid; it < S * 128; it += NT) {
        const int c32 = it & 31, t = ((it >> 8) << 1) + ((it >> 5) & 1), g = (it >> 6) & 3, ch = g * 32 + c32;
        if (g == 0) pool_item<2>(xn, pd, t, ch, g); else if (g == 1) pool_item<4>(xn, pd, t, ch, g); else if (g == 2) pool_item<8>(xn, pd, t, ch, g); else pool_item<16>(xn, pd, t, ch, g);
    }
}

__device__ __forceinline__ void conv_phase(const bf16_t* bcu, const float* cw, bf16_t* y, int gtid_unused, int NT) {
    const int gtid = blockIdx.x * 512 + fresh_tid();
#pragma unroll 2
    for (int it = gtid; it < S * 128; it += NT) {
        const int t = it >> 7, ch = it & 127; float acc[8] = {0.f, 0.f, 0.f, 0.f, 0.f, 0.f, 0.f, 0.f};
#pragma unroll
        for (int j = 0; j < 3; ++j) { const int tt = t - 2 + j;
            if (tt >= 0) { float c[8], uu[8]; unpack8(*(const u32x4*)(bcu + (size_t)tt * 3072 + 1024 + ch * 8), c); unpack8(*(const u32x4*)(bcu + (size_t)tt * 3072 + 2048 + ch * 8), uu);
                const f32x4 w0 = *(const f32x4*)(cw + j * D + ch * 8), w1 = *(const f32x4*)(cw + j * D + ch * 8 + 4);
#pragma unroll
                for (int e = 0; e < 4; ++e) { acc[e] += w0[e] * (c[e] * uu[e]); acc[4 + e] += w1[e] * (c[4 + e] * uu[4 + e]); } } }
        float b[8]; unpack8(*(const u32x4*)(bcu + (size_t)t * 3072 + ch * 8), b);
        u32x4 o; o.x = pk2(b[0] * acc[0], b[1] * acc[1]); o.y = pk2(b[2] * acc[2], b[3] * acc[3]); o.z = pk2(b[4] * acc[4], b[5] * acc[5]); o.w = pk2(b[6] * acc[6], b[7] * acc[7]);
        *(u32x4*)(y + (size_t)t * D + ch * 8) = o;
    }
}

__device__ __forceinline__ void qkt(f32x16& p0, f32x16& p1, ldsp Kslot, const bf16x8* qr, int r32, int hi) {
    ldsp kb = Kslot + hi * 1024 + r32 * 16;
    f32x16 z;
#pragma unroll
    for (int r = 0; r < 16; ++r) z[r] = 0.f;
    p0 = z; p1 = z;
    bf16x8 kf0[4], kf1[4];
#pragma unroll
    for (int d0 = 0; d0 < 4; ++d0) { kf0[d0] = *(const LAS bf16x8*)(kb + d0 * 2048); kf1[d0] = *(const LAS bf16x8*)(kb + d0 * 2048 + 512); }
    __builtin_amdgcn_s_setprio(1);
#pragma unroll
    for (int d0 = 0; d0 < 4; ++d0) {
        p0 = __builtin_amdgcn_mfma_f32_32x32x16_bf16(kf0[d0], qr[d0], p0, 0, 0, 0);
        p1 = __builtin_amdgcn_mfma_f32_32x32x16_bf16(kf1[d0], qr[d0], p1, 0, 0, 0);
    }
    __builtin_amdgcn_s_setprio(0);
}
__device__ __forceinline__ void qkt_acc(f32x16& p0, f32x16& p1, ldsp Kslot, const bf16x8* qr, int r32, int hi) {
    ldsp kb = Kslot + hi * 1024 + r32 * 16;
    bf16x8 kf0[4], kf1[4];
#pragma unroll
    for (int d0 = 0; d0 < 4; ++d0) { kf0[d0] = *(const LAS bf16x8*)(kb + d0 * 2048); kf1[d0] = *(const LAS bf16x8*)(kb + d0 * 2048 + 512); }
    __builtin_amdgcn_s_setprio(1);
#pragma unroll
    for (int d0 = 0; d0 < 4; ++d0) {
        p0 = __builtin_amdgcn_mfma_f32_32x32x16_bf16(kf0[d0], qr[d0], p0, 0, 0, 0);
        p1 = __builtin_amdgcn_mfma_f32_32x32x16_bf16(kf1[d0], qr[d0], p1, 0, 0, 0);
    }
    __builtin_amdgcn_s_setprio(0);
}
__device__ __forceinline__ s16x4 vtr(ldsp p) { return __builtin_bit_cast(s16x4, __builtin_amdgcn_ds_read_tr16_b64_v4i16((LAS s16x4*)p)); }
__device__ __forceinline__ void pv(f32x16* o, ldsp vp, const bf16x8 pa0, const bf16x8 pa1, const bf16x8 pa2, const bf16x8 pa3) {
    __builtin_amdgcn_s_setprio(1);
#pragma unroll
    for (int d0 = 0; d0 < 2; ++d0) {
#pragma unroll
        for (int ks = 0; ks < 4; ++ks) {
            const s16x4 lo = vtr(vp + d0 * 4096 + ks * 1024), hh = vtr(vp + d0 * 4096 + ks * 1024 + 512);
            const bf16x8 b = (bf16x8){lo[0], lo[1], lo[2], lo[3], hh[0], hh[1], hh[2], hh[3]};
            const bf16x8 a = ks == 0 ? pa0 : (ks == 1 ? pa1 : (ks == 2 ? pa2 : pa3));
            o[d0] = __builtin_amdgcn_mfma_f32_32x32x16_bf16(a, b, o[d0], 0, 0, 0);
        }
    }
    __builtin_amdgcn_s_setprio(0);
}
__device__ __forceinline__ float rowmax32(const f32x16& p0, const f32x16& p1) {
    float a = fmaxf(p0[0], p1[0]);
#pragma unroll
    for (int r = 1; r < 16; ++r) a = fmaxf(a, fmaxf(p0[r], p1[r]));
    return fmaxf(a, __shfl_xor(a, 32));
}
__device__ __forceinline__ void pack_p(const f32x16& p0, const f32x16& p1, bf16x8& a0, bf16x8& a1, bf16x8& a2, bf16x8& a3) {
    u32x4 w0, w1, w2, w3;
    w0 = (u32x4){pk2(p0[0], p0[1]), pk2(p0[2], p0[3]), pk2(p0[4], p0[5]), pk2(p0[6], p0[7])};
    w1 = (u32x4){pk2(p0[8], p0[9]), pk2(p0[10], p0[11]), pk2(p0[12], p0[13]), pk2(p0[14], p0[15])};
    w2 = (u32x4){pk2(p1[0], p1[1]), pk2(p1[2], p1[3]), pk2(p1[4], p1[5]), pk2(p1[6], p1[7])};
    w3 = (u32x4){pk2(p1[8], p1[9]), pk2(p1[10], p1[11]), pk2(p1[12], p1[13]), pk2(p1[14], p1[15])};
    a0 = __builtin_bit_cast(bf16x8, w0); a1 = __builtin_bit_cast(bf16x8, w1); a2 = __builtin_bit_cast(bf16x8, w2); a3 = __builtin_bit_cast(bf16x8, w3);
}
__device__ __forceinline__ void softmax_pv(f32x16& p0, f32x16& p1, float& m, float& l, f32x16* o, LAS float* wsf, ldsp vp, int r32, int hi) {
    const float rm = rowmax32(p0, p1);
    const float mn = fmaxf(m, rm), alpha = ex2(m - mn); m = mn;
    p0 = p0 - mn; p1 = p1 - mn;
#pragma unroll
    for (int r = 0; r < 16; ++r) { p0[r] = ex2(p0[r]); p1[r] = ex2(p1[r]); }
    float rs;
    { const f32x16 t = p0 + p1; typedef float f32x8 __attribute__((ext_vector_type(8)));
      const f32x8 t8 = __builtin_shufflevector(t, t, 0, 1, 2, 3, 4, 5, 6, 7) + __builtin_shufflevector(t, t, 8, 9, 10, 11, 12, 13, 14, 15);
      const f32x4 t4 = __builtin_shufflevector(t8, t8, 0, 1, 2, 3) + __builtin_shufflevector(t8, t8, 4, 5, 6, 7);
      rs = (t4[0] + t4[1]) + (t4[2] + t4[3]); }
    l = l * alpha + rs;
    if (!__all(alpha == 1.f)) {
        if (hi == 0) wsf[r32] = alpha;
#pragma unroll
        for (int r = 0; r < 16; ++r) { const float a = wsf[crow(r, hi)]; o[0][r] *= a; o[1][r] *= a; }
    }
    bf16x8 a0, a1, a2, a3; pack_p(p0, p1, a0, a1, a2, a3);
    pv(o, vp, a0, a1, a2, a3);
}
__device__ __forceinline__ u32x4 ld_k(const bf16_t* Kh, int pitch, int key0, int wid, int lane) { return *(const u32x4*)(Kh + (size_t)(key0 + lane) * pitch + wid * 8); }
__device__ __forceinline__ u32x4 ld_v(const bf16_t* Vh, int pitch, int key0, int wid, int lane) { return *(const u32x4*)(Vh + (size_t)(key0 + 16 * (wid & 3) + (lane >> 2)) * pitch + (wid >> 2) * 32 + (lane & 3) * 8); }
__device__ __forceinline__ void st_kv(ldsp slot, int wid, int lane, u32x4 v) { *(LAS u32x4*)(slot + wid * 1024 + lane * 16) = v; }

__device__ __forceinline__ void stage_o(const f32x16* o, const float* rs  , LAS bf16_t* stg, int r32, int hi) {
#pragma unroll
    for (int r = 0; r < 16; ++r) { const int orow = crow(r, hi);
#pragma unroll
        for (int d0 = 0; d0 < 2; ++d0) stg[orow * 64 + d0 * 32 + r32] = (bf16_t)f2bf(o[d0][r] * rs[r]); }
}

__device__ __forceinline__ void fox_unit(ldsp lds, int h, int qb, const bf16_t* Q, const bf16_t* Kb, const bf16_t* Vb, bf16_t* O, const float* lf, const unsigned* kmax, int tid, int lane, int wid) {
    asm volatile("" : "+v"(tid)); lane = tid & 63;
    const int r32 = lane & 31, hi = lane >> 5;
    LAS float* bias = (LAS float*)(lds + ATT_BIG);
    LAS float* part = (LAS float*)(lds + ATT_MISC);
    LAS float* wsf = (LAS float*)(lds + ATT_WSF) + wid * 64;
    const int q0 = qb * 256, nkeys = q0 + 256, NT = nkeys / 64;
    __syncthreads();
    const bf16_t* Kh = Kb + h * HD; const bf16_t* Vh = Vb + h * HD;
    const int tq = q0 + wid * 32 + r32;
    bf16x8 qr[4];
#pragma unroll
    for (int d0 = 0; d0 < 4; ++d0) qr[d0] = *(const bf16x8*)(Q + (size_t)tq * D + h * HD + d0 * 16 + hi * 8);
    u32x4 kreg = ld_k(Kh, D, (NT - 1) * 64, wid, lane), vreg = ld_v(Vh, D, (NT - 1) * 64, wid, lane);
    {
        const int pos0 = tid * 32; const bool act = pos0 < nkeys;
        f32x4 v[8]; float sum = 0.f;
#pragma unroll
        for (int i = 0; i < 8; ++i) { v[i] = act ? *(const f32x4*)(lf + (size_t)h * S + pos0 + 4 * i) : (f32x4){0.f, 0.f, 0.f, 0.f}; sum += (v[i].x + v[i].y) + (v[i].z + v[i].w); }
        float incl = sum;
#pragma unroll
        for (int off = 1; off < 64; off <<= 1) { const float t = __shfl_up(incl, off); if (lane >= off) incl += t; }
        if (lane == 63) part[wid] = incl;
        __syncthreads();
        float run = incl - sum, tot = 0.f;
        for (int w = 0; w < 8; ++w) { const float pw = part[w]; tot += pw; if (w < wid) run += pw; }
        if (act) {
#pragma unroll
            for (int i = 0; i < 8; ++i) { f32x4 c; run += v[i].x; c.x = (tot - run) * LOG2E; run += v[i].y; c.y = (tot - run) * LOG2E; run += v[i].z; c.z = (tot - run) * LOG2E; run += v[i].w; c.w = (tot - run) * LOG2E;
                *(LAS f32x4*)(bias + pos0 + 4 * i) = c; }
        }
    }
    float U;
    { float q2 = 0.f;
#pragma unroll
      for (int d0 = 0; d0 < 4; ++d0)
#pragma unroll
          for (int e = 0; e < 8; ++e) { const float f = bf2f((unsigned short)qr[d0][e]); q2 += f * f; }
      q2 += __shfl_xor(q2, 32);
      const float k2 = __builtin_bit_cast(float, kmax[h * 2]) + __builtin_bit_cast(float, kmax[h * 2 + 1]);
      U = sqrtf(q2 * k2) * 1.001f + 40.f; }
    float m = NEGF, l = 0.f; f32x16 o[2];
#pragma unroll
    for (int r = 0; r < 16; ++r) { o[0][r] = 0.f; o[1][r] = 0.f; }
    const int vlane = ((lane >> 4) & 1) * 32 + (lane & 3) * 8 + (4 * hi + ((lane & 15) >> 2)) * 64;
    st_kv(lds + ATT_BUF, wid, lane, kreg); st_kv(lds + ATT_BUF + 8192, wid, lane, vreg);
    if (NT > 1) { kreg = ld_k(Kh, D, (NT - 2) * 64, wid, lane); vreg = ld_v(Vh, D, (NT - 2) * 64, wid, lane); }
    __syncthreads();
    const int wq_lo = q0 + wid * 32;
    int done = 0;
    for (int t = NT - 1, it = 0; t >= 0; --t, ++it) {
        ldsp Ks = lds + ATT_BUF + (it & 1) * 16384; ldsp Vs = Ks + 8192;
        u32x4 kfar = kreg, vfar = vreg;
        if (t > 1) { kfar = ld_k(Kh, D, (t - 2) * 64, wid, lane); vfar = ld_v(Vh, D, (t - 2) * 64, wid, lane); }
        if (!done && 64 * t <= wq_lo + 31) {
            done = __all(U + bias[64 * t + 63] < m);
            if (!done) {
                f32x16 p0, p1;
#pragma unroll
                for (int a = 0; a < 4; ++a) { const f32x4 b0 = *(const LAS f32x4*)(bias + 64 * t + 8 * a + 4 * hi), b1 = *(const LAS f32x4*)(bias + 64 * t + 32 + 8 * a + 4 * hi);
#pragma unroll
                    for (int b = 0; b < 4; ++b) { p0[4 * a + b] = b0[b]; p1[4 * a + b] = b1[b]; } }
                qkt_acc(p0, p1, Ks, qr, r32, hi);
                if (64 * t + 63 > wq_lo) {
#pragma unroll
                    for (int r = 0; r < 16; ++r) { const int kv = 64 * t + crow(r, hi); if (kv > tq) p0[r] = NEGF; if (kv + 32 > tq) p1[r] = NEGF; }
                }
                softmax_pv(p0, p1, m, l, o, wsf, Vs + vlane, r32, hi);
            }
        }
        if (t > 0) { ldsp Kn = lds + ATT_BUF + ((it + 1) & 1) * 16384; st_kv(Kn, wid, lane, kreg); st_kv(Kn + 8192, wid, lane, vreg); }
        kreg = kfar; vreg = vfar;
        if (__syncthreads_and(done)) break;
    }
    l += __shfl_xor(l, 32);
    if (hi == 0) wsf[32 + r32] = l;
    float rs[16];
#pragma unroll
    for (int r = 0; r < 16; ++r) rs[r] = 1.f / wsf[32 + crow(r, hi)];
    LAS bf16_t* stg = (LAS bf16_t*)(lds + ATT_OST) + wid * 2048;
    stage_o(o, rs, stg, r32, hi);
    bf16_t* Ow = O + (size_t)(q0 + wid * 32) * D + h * HD;
#pragma unroll
    for (int i = 0; i < 4; ++i) { const int row = i * 8 + (lane >> 3), ch = lane & 7; const u32x4 v = *(const LAS u32x4*)(stg + row * 64 + ch * 8); *(u32x4*)(Ow + (size_t)row * D + ch * 8) = v; }
}

__device__ __forceinline__ void nsa_win_unit(ldsp lds, int kvh, int qblk, const bf16_t* Qn, const bf16_t* Kw, const bf16_t* Vw, const float* gates, bf16_t* O3, int tid, int lane, int wid) {
    asm volatile("" : "+v"(tid)); lane = tid & 63;
    const int r32 = lane & 31, hi = lane >> 5;
    LAS float* wsf = (LAS float*)(lds + ATT_WSF) + wid * 64;
    const int q0 = qblk * 64;
    const int tq = q0 + 8 * wid + (r32 >> 2), head = 4 * kvh + (r32 & 3);
    __syncthreads();
    bf16x8 qr[4];
#pragma unroll
    for (int d0 = 0; d0 < 4; ++d0) qr[d0] = *(const bf16x8*)(Qn + (size_t)tq * D + head * HD + d0 * 16 + hi * 8);
    float m = NEGF, l = 0.f; f32x16 o[2];
#pragma unroll
    for (int r = 0; r < 16; ++r) { o[0][r] = 0.f; o[1][r] = 0.f; }
    const int vlane = ((lane >> 4) & 1) * 32 + (lane & 3) * 8 + (4 * hi + ((lane & 15) >> 2)) * 64;
    const bf16_t* Kh = Kw + (size_t)kvh * S * 64; const bf16_t* Vh = Vw + (size_t)kvh * S * 64;
    const int t_hi = qblk, t_lo = qblk - 8 > 0 ? qblk - 8 : 0;
    u32x4 kreg = ld_k(Kh, 64, t_lo * 64, wid, lane), vreg = ld_v(Vh, 64, t_lo * 64, wid, lane);
    st_kv(lds + ATT_BUF, wid, lane, kreg); st_kv(lds + ATT_BUF + 8192, wid, lane, vreg);
    if (t_lo < t_hi) { kreg = ld_k(Kh, 64, (t_lo + 1) * 64, wid, lane); vreg = ld_v(Vh, 64, (t_lo + 1) * 64, wid, lane); }
    __syncthreads();
    for (int t = t_lo; t <= t_hi; ++t) {
        const int b = (t - t_lo) & 1;
        ldsp Ks = lds + ATT_BUF + b * 16384; ldsp Vs = Ks + 8192;
        u32x4 kfar = kreg, vfar = vreg;
        if (t + 2 <= t_hi) { kfar = ld_k(Kh, 64, (t + 2) * 64, wid, lane); vfar = ld_v(Vh, 64, (t + 2) * 64, wid, lane); }
        {
            f32x16 p0, p1; qkt(p0, p1, Ks, qr, r32, hi);
#pragma unroll
            for (int r = 0; r < 16; ++r) { const int kv = 64 * t + crow(r, hi);
                if (kv > tq || kv + 512 <= tq) p0[r] = NEGF;
                if (kv + 32 > tq || kv + 32 + 512 <= tq) p1[r] = NEGF; }
            softmax_pv(p0, p1, m, l, o, wsf, Vs + vlane, r32, hi);
        }
        if (t < t_hi) { ldsp Kn = lds + ATT_BUF + (b ^ 1) * 16384; st_kv(Kn, wid, lane, kreg); st_kv(Kn + 8192, wid, lane, vreg); }
        kreg = kfar; vreg = vfar;
        __syncthreads();
    }
    l += __shfl_xor(l, 32);
    if (hi == 0) wsf[32 + r32] = l;
    float rs[16];
#pragma unroll
    for (int r = 0; r < 16; ++r) { const int col = crow(r, hi); const float gt = gates[(size_t)(q0 + 8 * wid + (col >> 2)) * 48 + 32 + 4 * kvh + (col & 3)]; rs[r] = gt / wsf[32 + col]; }
    LAS bf16_t* stg = (LAS bf16_t*)(lds + ATT_OST) + wid * 2048;
    stage_o(o, rs, stg, r32, hi);
#pragma unroll
    for (int i = 0; i < 4; ++i) { const int row = i * 8 + (lane >> 3), ch = lane & 7; const u32x4 v = *(const LAS u32x4*)(stg + row * 64 + ch * 8);
        *(u32x4*)(O3 + (size_t)(q0 + 8 * wid + (row >> 2)) * 3072 + 2048 + (4 * kvh + (row & 3)) * HD + ch * 8) = v; }
}

__device__ __forceinline__ long lo64(const u32x4 v) { return (long)(((unsigned long long)v.y << 32) | v.x); }
__device__ __forceinline__ long hi64(const u32x4 v) { return (long)(((unsigned long long)v.w << 32) | v.z); }
__device__ __forceinline__ void sel_load4(u32x4* f, const unsigned char* B, int j) {
    const unsigned char* p = B + (size_t)j * 4096;
#pragma unroll
    for (int g4 = 0; g4 < 4; ++g4) f[g4] = *(const u32x4*)(p + g4 * 1024);
}
__device__ __forceinline__ void sel_fetch4(u32x4* f, const unsigned char* B, ldsp lc, int j, int cur) {
    const int jj = j < 0 ? 0 : j;
    const int fs = jj == 0 ? 0 : (jj == cur ? 2 : (jj == cur - 1 ? 1 : -1));
    if (fs >= 0) {
#pragma unroll
        for (int g4 = 0; g4 < 4; ++g4) f[g4] = *(const LAS u32x4*)(lc + fs * 8192 + g4 * 1024);
    } else sel_load4(f, B, jj);
}
__device__ __forceinline__ void sel_compute(const u32x4* fK, const u32x4* fV, const long* Qb, bool diag, int lim, int kg, float& ms, float& ls, f32x4* oa) {
    f32x4 sc[4];
    __builtin_amdgcn_s_setprio(1);
#pragma unroll
    for (int g4 = 0; g4 < 4; ++g4) { sc[g4] = __builtin_amdgcn_mfma_f32_16x16x32_fp8_fp8(lo64(fK[g4]), Qb[0], (f32x4){0.f, 0.f, 0.f, 0.f}, 0, 0, 0); sc[g4] = __builtin_amdgcn_mfma_f32_16x16x32_fp8_fp8(hi64(fK[g4]), Qb[1], sc[g4], 0, 0, 0); }
    __builtin_amdgcn_s_setprio(0);
    if (diag) {
#pragma unroll
        for (int g4 = 0; g4 < 4; ++g4)
#pragma unroll
            for (int r = 0; r < 4; ++r) if (16 * g4 + 4 * kg + r > lim) sc[g4][r] = NEGF; }
    float lm = fmaxf(fmaxf(sc[0][0], sc[0][1]), fmaxf(sc[0][2], sc[0][3]));
#pragma unroll
    for (int g4 = 1; g4 < 4; ++g4) lm = fmaxf(lm, fmaxf(fmaxf(sc[g4][0], sc[g4][1]), fmaxf(sc[g4][2], sc[g4][3])));
    lm *= C2;
    if (__any(lm > ms + 8.f)) {
        float rm = fmaxf(lm, __shfl_xor(lm, 16)); rm = fmaxf(rm, __shfl_xor(rm, 32));
        const float mn = fmaxf(ms, rm), alpha = ex2(ms - mn); ms = mn; ls *= alpha;
#pragma unroll
        for (int dg = 0; dg < 4; ++dg) oa[dg] = oa[dg] * alpha;
    }
#pragma unroll
    for (int g4 = 0; g4 < 4; ++g4) { sc[g4] = sc[g4] * C2 - ms;
#pragma unroll
        for (int r = 0; r < 4; ++r) sc[g4][r] = ex2(sc[g4][r]); }
    { const f32x4 t4 = (sc[0] + sc[1]) + (sc[2] + sc[3]); ls += (t4[0] + t4[1]) + (t4[2] + t4[3]); }
    long Pb[2];
#pragma unroll
    for (int s2 = 0; s2 < 2; ++s2) Pb[s2] = pk8_fp8(sc[2 * s2][0], sc[2 * s2][1], sc[2 * s2][2], sc[2 * s2][3], sc[2 * s2 + 1][0], sc[2 * s2 + 1][1], sc[2 * s2 + 1][2], sc[2 * s2 + 1][3]);
    __builtin_amdgcn_s_setprio(1);
#pragma unroll
    for (int dg = 0; dg < 4; ++dg) { oa[dg] = __builtin_amdgcn_mfma_f32_16x16x32_fp8_fp8(lo64(fV[dg]), Pb[0], oa[dg], 0, 0, 0); oa[dg] = __builtin_amdgcn_mfma_f32_16x16x32_fp8_fp8(hi64(fV[dg]), Pb[1], oa[dg], 0, 0, 0); }
    __builtin_amdgcn_s_setprio(0);
}

__device__ __forceinline__ float quad_sum(float v) { v += __shfl_xor(v, 1); v += __shfl_xor(v, 2); return v; }

__device__ __forceinline__ void nsa_cs_unit(ldsp lds, int kvh, int qblk, const bf16_t* Qn, const bf16_t* Kc, const bf16_t* Vc, const bf16_t* Ksl, const bf16_t* Vst, const bf16_t* Kw, const bf16_t* Vw, const float* gates, bf16_t* O3, int tid, int lane, int wid) {
    asm volatile("" : "+v"(tid)); lane = tid & 63;
    const int r32 = lane & 31, hi = lane >> 5;
    LAS float* wsf = (LAS float*)(lds + ATT_WSF) + wid * 64;
    LAS float* imp = (LAS float*)(lds + ATT_BIG);
    LAS int* sel = (LAS int*)(lds + ATT_SEL);
    const int q0 = qblk * 64;
    const int qloc = 8 * wid + (r32 >> 2);
    const int tq = q0 + qloc, head = 4 * kvh + (r32 & 3);
    __syncthreads();
    for (int i = tid; i < 64 * 256 / 4; i += 512) ((LAS f32x4*)imp)[i] = (f32x4){0.f, 0.f, 0.f, 0.f};
    bf16x8 qr[4];
#pragma unroll
    for (int d0 = 0; d0 < 4; ++d0) qr[d0] = *(const bf16x8*)(Qn + (size_t)tq * D + head * HD + d0 * 16 + hi * 8);
    const int vlane = ((lane >> 4) & 1) * 32 + (lane & 3) * 8 + (4 * hi + ((lane & 15) >> 2)) * 64;
    const bf16_t* Kh = Kc + (size_t)kvh * 1024 * 64; const bf16_t* Vh = Vc + (size_t)kvh * 1024 * 64;
    int ncmp = q0 / 16 + 3; if (ncmp > NCMP) ncmp = NCMP;
    const int NTc = (ncmp + 63) / 64;
    float m = NEGF, l = 0.f;
    {
        u32x4 kreg = ld_k(Kh, 64, 0, wid, lane);
        st_kv(lds + ATT_BUF, wid, lane, kreg);
        if (NTc > 1) kreg = ld_k(Kh, 64, 64, wid, lane);
        __syncthreads();
        for (int t = 0; t < NTc; ++t) {
            ldsp Ks = lds + ATT_BUF + (t & 1) * 16384;
            u32x4 kfar = kreg;
            if (t + 2 < NTc) kfar = ld_k(Kh, 64, (t + 2) * 64, wid, lane);
            f32x16 p0, p1; qkt(p0, p1, Ks, qr, r32, hi);
            if (1024 * t + 1039 > q0) {
#pragma unroll
                for (int r = 0; r < 16; ++r) { const int n = 64 * t + crow(r, hi); if (16 * n + 31 > tq) p0[r] = NEGF; if (16 * (n + 32) + 31 > tq) p1[r] = NEGF; } }
            const float rm = rowmax32(p0, p1); const float mn = fmaxf(m, rm), alpha = ex2(m - mn); m = mn; float rs;
            p0 = p0 - mn; p1 = p1 - mn;
#pragma unroll
            for (int r = 0; r < 16; ++r) { p0[r] = ex2(p0[r]); p1[r] = ex2(p1[r]); }
            { const f32x16 t = p0 + p1; typedef float f32x8 __attribute__((ext_vector_type(8)));
              const f32x8 t8 = __builtin_shufflevector(t, t, 0, 1, 2, 3, 4, 5, 6, 7) + __builtin_shufflevector(t, t, 8, 9, 10, 11, 12, 13, 14, 15);
              const f32x4 t4 = __builtin_shufflevector(t8, t8, 0, 1, 2, 3) + __builtin_shufflevector(t8, t8, 4, 5, 6, 7);
              rs = (t4[0] + t4[1]) + (t4[2] + t4[3]); }
            l = l * alpha + rs;
            if (t + 1 < NTc) st_kv(lds + ATT_BUF + ((t + 1) & 1) * 16384, wid, lane, kreg);
            kreg = kfar;
            __syncthreads();
        }
        l += __shfl_xor(l, 32);
    }
    const bool rowvalid = m > -1e29f;
    const float mfin = rowvalid ? m + log2f(l) : 1e30f;
    f32x16 o[2];
#pragma unroll
    for (int r = 0; r < 16; ++r) { o[0][r] = 0.f; o[1][r] = 0.f; }
    {
        float carry = 0.f;
        u32x4 kreg = ld_k(Kh, 64, 0, wid, lane), vreg = ld_v(Vh, 64, 0, wid, lane);
        st_kv(lds + ATT_BUF, wid, lane, kreg); st_kv(lds + ATT_BUF + 8192, wid, lane, vreg);
        if (NTc > 1) { kreg = ld_k(Kh, 64, 64, wid, lane); vreg = ld_v(Vh, 64, 64, wid, lane); }
        __syncthreads();
        for (int t = 0; t < NTc; ++t) {
            ldsp Ks = lds + ATT_BUF + (t & 1) * 16384; ldsp Vs = Ks + 8192;
            u32x4 kfar = kreg, vfar = vreg;
            if (t + 2 < NTc) { kfar = ld_k(Kh, 64, (t + 2) * 64, wid, lane); vfar = ld_v(Vh, 64, (t + 2) * 64, wid, lane); }
            f32x16 p0, p1; qkt(p0, p1, Ks, qr, r32, hi);
            if (1024 * t + 1039 > q0) {
#pragma unroll
                for (int r = 0; r < 16; ++r) { const int n = 64 * t + crow(r, hi);
                    p0[r] = (16 * n + 31 > tq) ? 0.f : ex2(p0[r] - mfin);
                    p1[r] = (16 * (n + 32) + 31 > tq) ? 0.f : ex2(p1[r] - mfin); }
            } else {
                p0 = p0 - mfin; p1 = p1 - mfin;
#pragma unroll
                for (int r = 0; r < 16; ++r) { p0[r] = ex2(p0[r]); p1[r] = ex2(p1[r]); }
            }
            float G0[4], G1[4], e0[4], e1[4];
#pragma unroll
            for (int a = 0; a < 4; ++a) { G0[a] = quad_sum((p0[4 * a] + p0[4 * a + 1]) + (p0[4 * a + 2] + p0[4 * a + 3])); G1[a] = quad_sum((p1[4 * a] + p1[4 * a + 1]) + (p1[4 * a + 2] + p1[4 * a + 3]));
                e0[a] = quad_sum(p0[4 * a + 3]); e1[a] = quad_sum(p1[4 * a + 3]); }
            float x0[4], x1[4];
#pragma unroll
            for (int a = 0; a < 4; ++a) { x0[a] = __shfl_xor(e0[a], 32); x1[a] = __shfl_xor(e1[a], 32); }
            float ex0[4], ex1[4];
            if (hi == 1) {
#pragma unroll
                for (int a = 0; a < 4; ++a) { ex0[a] = x0[a]; ex1[a] = x1[a]; }
            } else {
                ex0[0] = carry; ex0[1] = x0[0]; ex0[2] = x0[1]; ex0[3] = x0[2];
                ex1[0] = x0[3]; ex1[1] = x1[0]; ex1[2] = x1[1]; ex1[3] = x1[2];
                carry = x1[3];
            }
            if ((r32 & 3) == 0) {
#pragma unroll
                for (int a = 0; a < 4; ++a) { imp[qloc * 256 + 16 * t + 2 * a + hi] = G0[a] + ex0[a]; imp[qloc * 256 + 16 * t + 8 + 2 * a + hi] = G1[a] + ex1[a]; }
            }
            bf16x8 a0, a1, a2, a3; pack_p(p0, p1, a0, a1, a2, a3);
            pv(o, Vs + vlane, a0, a1, a2, a3);
            if (t + 1 < NTc) { ldsp Kn = lds + ATT_BUF + ((t + 1) & 1) * 16384; st_kv(Kn, wid, lane, kreg); st_kv(Kn + 8192, wid, lane, vreg); }
            kreg = kfar; vreg = vfar;
            __syncthreads();
        }
    }
    LAS bf16_t* stg = (LAS bf16_t*)(lds + ATT_OST) + wid * 2048;
    {
        float rs[16];
#pragma unroll
        for (int r = 0; r < 16; ++r) { const int col = crow(r, hi); rs[r] = gates[(size_t)(q0 + 8 * wid + (col >> 2)) * 48 + 4 * kvh + (col & 3)]; }
        stage_o(o, rs, stg, r32, hi);
    }
    for (int qi = 0; qi < 8; ++qi) {
        const int ql = 8 * wid + qi, t = q0 + ql, cur = t >> 6;
        unsigned long long key[4];
#pragma unroll
        for (int i = 0; i < 4; ++i) { const int j = lane + 64 * i; float v = imp[ql * 256 + j];
            if (j == 0 || j == cur || j == cur - 1) v = 1e9f;
            if (j > cur) v = NEGF;
            unsigned ub = __builtin_bit_cast(unsigned, v); ub = (ub & 0x80000000u) ? ~ub : (ub | 0x80000000u);
            key[i] = ((unsigned long long)ub << 8) | (unsigned)(255 - j); }
        unsigned long long T = 0ull;
        for (int b = 39; b >= 0; --b) { const unsigned long long Tt = T | (1ull << b); int cnt = 0;
#pragma unroll
            for (int i = 0; i < 4; ++i) cnt += __popcll(__ballot(key[i] >= Tt));
            if (cnt >= 16) T = Tt;
            if (cnt == 16) break; }
        int base = 0;
#pragma unroll
        for (int i = 0; i < 4; ++i) { const int j = lane + 64 * i; const bool in = key[i] >= T; const unsigned long long mk = __ballot(in);
            const int pos = base + __popcll(mk & ((1ull << lane) - 1ull));
            if (in && pos < 16) sel[ql * 16 + pos] = (j <= cur) ? j : -1;
            base += __popcll(mk); }
    }
    { const unsigned char* gsrc = (tid < 256 ? (const unsigned char*)Ksl + (size_t)kvh * S * 64 : (const unsigned char*)Vst + (size_t)kvh * 256 * 4096) + (size_t)(tid & 255) * 16;
#pragma unroll
      for (int sl = 0; sl < 3; ++sl) { const int jb_ = sl == 0 ? 0 : (sl == 1 ? (qblk > 0 ? qblk - 1 : 0) : qblk);
          *(LAS u32x4*)(lds + ATT_BUF + sl * 8192 + (tid < 256 ? 0 : 4096) + (tid & 255) * 16) = *(const u32x4*)(gsrc + (size_t)jb_ * 4096); }
    }
    __syncthreads();
    {
        const int n = lane & 15, kg = lane >> 4;
        const unsigned char* Kb = (const unsigned char*)Ksl + (size_t)kvh * S * 64 + (size_t)n * 64 + 16 * kg; const unsigned char* Vb = (const unsigned char*)Vst + (size_t)kvh * 256 * 4096 + (size_t)n * 64 + 16 * kg;
        ldsp lck = lds + ATT_BUF + n * 64 + 16 * kg; ldsp lcv = lck + 4096;
        const int cur = qblk;
        u32x4 Ks[2][4], Vs2[2][4];
        const u32x4 zq = {0u, 0u, 0u, 0u};
        const bf16_t* qp0 = Qn + (size_t)(q0 + 8 * wid) * D + (4 * kvh + (n & 3)) * HD + 16 * kg;
        u32x4 qan = n < 4 ? *(const u32x4*)qp0 : zq, qbn = n < 4 ? *(const u32x4*)(qp0 + 8) : zq;
        int jn0 = __builtin_amdgcn_readfirstlane(sel[(8 * wid) * 16]);
        sel_fetch4(Ks[0], Kb, lck, jn0, cur); sel_fetch4(Vs2[0], Vb, lcv, jn0, cur);
        for (int qi = 0; qi < 8; ++qi) {
            const int ql = 8 * wid + qi, t = q0 + ql, lim = t & 63;
            long Qb[2];
            { float fa8[8], fb8[8]; unpack8(qan, fa8); unpack8(qbn, fb8);
              const float ic = 1.f / C2;
              Qb[0] = pk8_fp8(fa8[0] * ic, fa8[1] * ic, fa8[2] * ic, fa8[3] * ic, fa8[4] * ic, fa8[5] * ic, fa8[6] * ic, fa8[7] * ic);
              Qb[1] = pk8_fp8(fb8[0] * ic, fb8[1] * ic, fb8[2] * ic, fb8[3] * ic, fb8[4] * ic, fb8[5] * ic, fb8[6] * ic, fb8[7] * ic); }
            if (qi + 1 < 8) { const bf16_t* qp = qp0 + (size_t)(qi + 1) * D; qan = n < 4 ? *(const u32x4*)qp : zq; qbn = n < 4 ? *(const u32x4*)(qp + 8) : zq; }
            float ms = NEGF, ls = 0.f; f32x4 oa[4];
#pragma unroll
            for (int dg = 0; dg < 4; ++dg) oa[dg] = (f32x4){0.f, 0.f, 0.f, 0.f};
#pragma unroll
            for (int it = 0; it < 16; ++it) {
                int jn1 = -1;
                if (it + 1 < 16) { jn1 = __builtin_amdgcn_readfirstlane(sel[ql * 16 + it + 1]); sel_fetch4(Ks[(it + 1) & 1], Kb, lck, jn1, cur); sel_fetch4(Vs2[(it + 1) & 1], Vb, lcv, jn1, cur); }
                else if (qi + 1 < 8) { jn1 = __builtin_amdgcn_readfirstlane(sel[(ql + 1) * 16]); sel_fetch4(Ks[0], Kb, lck, jn1, cur); sel_fetch4(Vs2[0], Vb, lcv, jn1, cur); }
                const int lim_i = jn0 < 0 ? -1 : (jn0 == cur ? lim : 63);
                sel_compute(Ks[it & 1], Vs2[it & 1], Qb, lim_i < 63, lim_i, kg, ms, ls, oa);
                jn0 = jn1;
                __builtin_amdgcn_sched_barrier(0);
            }
            ls += __shfl_xor(ls, 16); ls += __shfl_xor(ls, 32);
            if (n < 4) { const float gs = gates[(size_t)t * 48 + 16 + 4 * kvh + n] / ls;
#pragma unroll
                for (int dg = 0; dg < 4; ++dg) { const f32x4 v = oa[dg] * gs; LAS u32x2* sp = (LAS u32x2*)(stg + (qi * 4 + n) * 64 + 16 * dg + 4 * kg); const u32x2 ov = *sp;
                    u32x2 w; w.x = pk2(v[0] + __builtin_bit_cast(float, ov.x << 16), v[1] + __builtin_bit_cast(float, ov.x & 0xffff0000u)); w.y = pk2(v[2] + __builtin_bit_cast(float, ov.y << 16), v[3] + __builtin_bit_cast(float, ov.y & 0xffff0000u));
                    *sp = w; } }
        }
    }
    {
        float m2 = NEGF, l2 = 0.f;
#pragma unroll
        for (int r = 0; r < 16; ++r) { o[0][r] = 0.f; o[1][r] = 0.f; }
        const bf16_t* Kwh = Kw + (size_t)kvh * S * 64; const bf16_t* Vwh = Vw + (size_t)kvh * S * 64;
        const int t_hi = qblk, t_lo = qblk - 8 > 0 ? qblk - 8 : 0;
        __syncthreads();
        u32x4 kreg = ld_k(Kwh, 64, t_lo * 64, wid, lane), vreg = ld_v(Vwh, 64, t_lo * 64, wid, lane);
        st_kv(lds + ATT_BUF, wid, lane, kreg); st_kv(lds + ATT_BUF + 8192, wid, lane, vreg);
        if (t_lo < t_hi) { kreg = ld_k(Kwh, 64, (t_lo + 1) * 64, wid, lane); vreg = ld_v(Vwh, 64, (t_lo + 1) * 64, wid, lane); }
        __syncthreads();
        for (int t = t_lo; t <= t_hi; ++t) {
            const int b = (t - t_lo) & 1;
            ldsp Ks = lds + ATT_BUF + b * 16384; ldsp Vs = Ks + 8192;
            u32x4 kfar = kreg, vfar = vreg;
            if (t + 2 <= t_hi) { kfar = ld_k(Kwh, 64, (t + 2) * 64, wid, lane); vfar = ld_v(Vwh, 64, (t + 2) * 64, wid, lane); }
            {
                f32x16 p0, p1; qkt(p0, p1, Ks, qr, r32, hi);
                if (t == t_hi || t == qblk - 8) {
#pragma unroll
                    for (int r = 0; r < 16; ++r) { const int kv = 64 * t + crow(r, hi);
                        if (kv > tq || kv + 512 <= tq) p0[r] = NEGF;
                        if (kv + 32 > tq || kv + 32 + 512 <= tq) p1[r] = NEGF; } }
                softmax_pv(p0, p1, m2, l2, o, wsf, Vs + vlane, r32, hi);
            }
            if (t < t_hi) { ldsp Kn = lds + ATT_BUF + (b ^ 1) * 16384; st_kv(Kn, wid, lane, kreg); st_kv(Kn + 8192, wid, lane, vreg); }
            kreg = kfar; vreg = vfar;
            __syncthreads();
        }
        l2 += __shfl_xor(l2, 32);
        if (hi == 0) wsf[32 + r32] = l2;
#pragma unroll
        for (int r = 0; r < 16; ++r) { const int col = crow(r, hi); const float gt = gates[(size_t)(q0 + 8 * wid + (col >> 2)) * 48 + 32 + 4 * kvh + (col & 3)]; const float rsw = gt / wsf[32 + col];
#pragma unroll
            for (int d0 = 0; d0 < 2; ++d0) { LAS bf16_t* sp = stg + col * 64 + d0 * 32 + r32; *sp = (bf16_t)f2bf(bf2f(*sp) + o[d0][r] * rsw); } }
#pragma unroll
        for (int i = 0; i < 4; ++i) { const int row = i * 8 + (lane >> 3), ch = lane & 7; const u32x4 v = *(const LAS u32x4*)(stg + row * 64 + ch * 8);
            *(u32x4*)(O3 + (size_t)(q0 + 8 * wid + (row >> 2)) * D + (4 * kvh + (row & 3)) * HD + ch * 8) = v; }
    }
}


#define XB_TMO      128
#define XB_XCNT(j)  (256  + 64 * (j))
#define XB_XSUB(j)  (1280 + 64 * (j))
#define XB_XGEN(j)  (2304 + 64 * (j))
#define XB_TOP      3328
#define XB_TOPGEN   3392
#define XCD_BAR_WORDS 3456
#define XB_SPIN_CAP (1u << 18)
__device__ __forceinline__ unsigned xb_ld(unsigned* p)              { return __hip_atomic_load(p, __ATOMIC_RELAXED, __HIP_MEMORY_SCOPE_AGENT); }
__device__ __forceinline__ unsigned xb_add(unsigned* p, unsigned v) { return __hip_atomic_fetch_add(p, v, __ATOMIC_RELAXED, __HIP_MEMORY_SCOPE_AGENT); }
__device__ __forceinline__ unsigned xb_xcc_id() { return (unsigned)__builtin_amdgcn_s_getreg((3 << 11) | 20) & 0xFu; }
#define XB_SPIN(cond, bar) do { unsigned _sp = 0; while (cond) { __builtin_amdgcn_s_sleep(1); \
    if ((++_sp & 255u) == 0u) { if (xb_ld(&(bar)[XB_TMO])) break; if (_sp > XB_SPIN_CAP) { atomicAdd(&(bar)[XB_TMO], 1u); break; } } } } while (0)
struct XcdBarrier { unsigned* bar; unsigned x; volatile LAS unsigned* st; };
__device__ __forceinline__ XcdBarrier xcd_barrier_post(unsigned* bar, volatile LAS unsigned* st) {
    XcdBarrier b; b.bar = bar; b.x = xb_xcc_id(); b.st = st;
    if (threadIdx.x == 0) (void)xb_add(&bar[XB_XCNT(b.x)], 1u);
    return b;
}
__device__ __forceinline__ void xcd_barrier_complete(unsigned* bar, unsigned x, unsigned& nloc, unsigned& nx) {
    const unsigned G = gridDim.x * gridDim.y * gridDim.z;
    unsigned sum, cnt, mine, sp = 0u;
    for (;;) {
        sum = 0u; cnt = 0u; mine = 0u;
#pragma unroll
        for (unsigned j = 0; j < 16; ++j) { const unsigned c = xb_ld(&bar[XB_XCNT(j)]); sum += c; cnt += (c > 0u) ? 1u : 0u; mine = (j == x) ? c : mine; }
        if (sum == G) break;
        __builtin_amdgcn_s_sleep(1);
        if ((++sp & 255u) == 0u) { if (xb_ld(&bar[XB_TMO])) break; if (sp > XB_SPIN_CAP) { atomicAdd(&bar[XB_TMO], 1u); break; } }
    }
    nloc = mine > 0u ? mine : 1u; nx = cnt > 0u ? cnt : 1u;
}
__device__ __forceinline__ void xcd_barrier(const XcdBarrier& b) {
    asm volatile("s_waitcnt vmcnt(0)" ::: "memory");
    __syncthreads();
    if (threadIdx.x == 0) {
        unsigned* bar = b.bar;
        __builtin_amdgcn_s_waitcnt(0);
        unsigned nloc = b.st[0], nx = b.st[1];
        if (nloc == 0u) { xcd_barrier_complete(bar, b.x, nloc, nx); b.st[0] = nloc; b.st[1] = nx; }
        const unsigned old = xb_add(&bar[XB_XSUB(b.x)], 1u);
        const unsigned gen = old / nloc;
        if (old + 1u == (gen + 1u) * nloc) {
            __builtin_amdgcn_fence(__ATOMIC_RELEASE, "agent");
            asm volatile("s_waitcnt vmcnt(0)" ::: "memory");
            const unsigned og = xb_add(&bar[XB_TOP], 1u);
            const unsigned tg = og / nx;
            if (og + 1u == (tg + 1u) * nx) xb_add(&bar[XB_TOPGEN], 1u);
            else XB_SPIN(xb_ld(&bar[XB_TOPGEN]) == tg, bar);
            __builtin_amdgcn_fence(__ATOMIC_ACQUIRE, "agent");
            xb_add(&bar[XB_XGEN(b.x)], 1u);
            asm volatile("s_waitcnt vmcnt(0)" ::: "memory");
        } else {
            XB_SPIN(xb_ld(&bar[XB_XGEN(b.x)]) == gen, bar);
            __builtin_amdgcn_fence(__ATOMIC_ACQUIRE, "agent");
            asm volatile("s_waitcnt vmcnt(0)" ::: "memory");
        }
    }
    __syncthreads();
}

struct Args { const float* in[36]; float* out; unsigned char* ws; };

__global__ void __launch_bounds__(512, 2) mega_fwd(Args a) {
    extern __shared__ __attribute__((aligned(16))) unsigned char smem[];
    ldsp lds = (ldsp)smem;
    const int tid = threadIdx.x, lane = tid & 63, wid = __builtin_amdgcn_readfirstlane(tid >> 6);
    const int G = gridDim.x, bid = blockIdx.x;
    const int gw = bid * 8 + wid, NGW = G * 8, NTH = G * 512;
#define GTID() ((int)(blockIdx.x * 512 + fresh_tid()))
    unsigned char* ws = a.ws;
    float* h = a.out;
    bf16_t* XN = (bf16_t*)(ws + WS_XN); bf16_t* HID = (bf16_t*)(ws + WS_HID);
    bf16_t* W1T = (bf16_t*)(ws + WS_W1T); bf16_t* W2T = (bf16_t*)(ws + WS_W2T);
    bf16_t* WMIX = (bf16_t*)(ws + WS_WMIX);
    LAS float* scr = (LAS float*)(lds + wid * 16384);
    if (tid < 2) ((volatile LAS unsigned*)(lds + LDS_XB))[tid] = 0u;
    __syncthreads();
    const XcdBarrier xbar = xcd_barrier_post((unsigned*)(ws + WS_BAR), (volatile LAS unsigned*)(lds + LDS_XB));
#define GSYNC() xcd_barrier(xbar)
    const int* positions = (const int*)a.in[1];
    float* cosT = (float*)(ws + WS_COS); float* sinT = (float*)(ws + WS_SIN);

#define GEMM(EPI_T, EPI, Aptr, Bptr, M_, N_, K_, LDA_, APN_, ALIGN_, CID_) do { pg8::Gemm g_{(const bf16_t*)(Aptr), (const bf16_t*)(Bptr), (M_), (N_), (K_), (LDA_), (size_t)(APN_)}; pg8::StaticOrder S_; S_.init((M_), (N_), G, (CID_)); \
        pg8::gemm_phase<EPI_T, ALIGN_>(lds, g_, S_, (EPI)); } while (0)
#define CVT_MLP(i1, i2) do { cvt_mat(a.in[i1], D, FF, FF, W1T, D, 0, 0, scr, gw, NGW, lane); cvt_mat(a.in[i2], FF, D, D, W2T, FF, 0, 0, scr, gw, NGW, lane); } while (0)
#define MLP(i) do { \
        { pg8::EpiBf16<1> E_{HID, FF}; GEMM(pg8::EpiBf16<1>, E_, XN, W1T, S, FF, D, D, 0, true, bid); } \
        GSYNC(); \
        { pg8::EpiRes E_{h, h, nullptr}; GEMM(pg8::EpiRes, E_, HID, W2T, S, D, FF, FF, 0, false, bid); } \
        GSYNC(); } while (0)

    cvt_mat(a.in[3], D, 3 * D, 3 * D, WMIX, D, 0, 0, scr, gw, NGW, lane);
    cvt_mat(a.in[4], D, NH, 256, WMIX, D, 3 * D, 0, scr, gw, NGW, lane);
    cvt_mat(a.in[6], D, D, D, (bf16_t*)(ws + WS_WMIX + WM_B), D, 0, 0, scr, gw, NGW, lane);
    for (int it = GTID(); it < S * 8; it += NTH) { const int t = it >> 3, i = it & 7; const float inv = powf(500000.f, -(float)(2 * i) / 16.f); const float ang = (float)positions[t] * inv; cosT[it] = cosf(ang); sinT[it] = sinf(ang); }
    { const int g_ = GTID(); if (g_ < 32) ((unsigned*)(ws + WS_KMAX))[g_] = 0u; }
    norm_phase(a.in[0], a.in[2], XN, gw, NGW, lane);
    GSYNC();
    { pg8::EpiQKV E_{(bf16_t*)(ws + WS_FQ), (bf16_t*)(ws + WS_FK), (bf16_t*)(ws + WS_FV), (float*)(ws + WS_LF), a.in[5], (unsigned*)(ws + WS_KMAX)}; GEMM(pg8::EpiQKV, E_, XN, WMIX, S, NQKV_PAD, D, D, 0, true, bid); }
    if (G == 256) { cvt_mat<64>(a.in[8], D, FF, FF, W1T, D, 0, 0, scr, gw, 192 * 8, lane); cvt_mat<64>(a.in[9], FF, D, D, W2T, FF, 0, 0, scr, gw, 192 * 8, lane); }
    GSYNC();
    for (int qn = 0; qn < 8; ++qn) {
        const int hq = (int)((xb_xcc_id() + (unsigned)qn) & 7u);
        for (;;) {
            __syncthreads();
            if (tid == 0) *(volatile LAS unsigned*)(lds + ATT_MISC + 64) = atomicAdd((unsigned*)(ws + WS_BAR + 15 * 1024 + 512 + 64 * hq), 1u);
            __syncthreads();
            const unsigned u = *(volatile LAS unsigned*)(lds + ATT_MISC + 64);
            if (u >= 128u) break;
            fox_unit(lds, 2 * hq + (int)(u & 1u), 63 - (int)(u >> 1), (const bf16_t*)(ws + WS_FQ), (const bf16_t*)(ws + WS_FK), (const bf16_t*)(ws + WS_FV), (bf16_t*)(ws + WS_FO), (const float*)(ws + WS_LF), (const unsigned*)(ws + WS_KMAX), tid, lane, wid);
        }
    }
    __syncthreads();
    if (G != 256) CVT_MLP(8, 9);
    GSYNC();
    { pg8::EpiRes E_{a.in[0], h, nullptr}; GEMM(pg8::EpiRes, E_, ws + WS_FO, ws + WS_WMIX + WM_B, S, D, D, D, 0, false, bid); }
    GSYNC();
    norm_phase(h, a.in[7], XN, gw, NGW, lane);
    GSYNC();
    MLP(0);
    norm_phase(h, a.in[10], XN, gw, NGW, lane);
    for (int g4 = 0; g4 < 4; ++g4) cvt_mat(a.in[11] + (size_t)g4 * 65536, 256, 256, 256, WMIX, 256, g4 * 256, 0, scr, gw, NGW, lane);
    CVT_MLP(14, 15);
    GSYNC();
    pool_diff_phase(XN, (bf16_t*)(ws + WS_PD), 0, NTH);
    GSYNC();
    { pg8::EpiRes E_{h, h, a.in[12]}; GEMM(pg8::EpiRes, E_, ws + WS_PD, WMIX, S, D, 256, 256, (size_t)S * 256 * 2, false, bid); }
    GSYNC();
    norm_phase(h, a.in[13], XN, gw, NGW, lane);
    GSYNC();
    MLP(1);
    norm_phase(h, a.in[16], XN, gw, NGW, lane);
    cvt_mat(a.in[17], D, 3 * D, 3 * D, WMIX, D, 0, 0, scr, gw, NGW, lane);
    cvt_mat(a.in[19], D, D, D, (bf16_t*)(ws + WS_WMIX + WM_B), D, 0, 0, scr, gw, NGW, lane);
    CVT_MLP(21, 22);
    GSYNC();
    { pg8::EpiBf16<0> E_{(bf16_t*)(ws + WS_BCU), 3 * D}; GEMM(pg8::EpiBf16<0>, E_, XN, WMIX, S, 3 * D, D, D, 0, true, bid); }
    GSYNC();
    conv_phase((const bf16_t*)(ws + WS_BCU), a.in[18], (bf16_t*)(ws + WS_CY), 0, NTH);
    GSYNC();
    { pg8::EpiRes E_{h, h, nullptr}; GEMM(pg8::EpiRes, E_, ws + WS_CY, ws + WS_WMIX + WM_B, S, D, D, D, 0, false, bid); }
    GSYNC();
    norm_phase(h, a.in[20], XN, gw, NGW, lane);
    GSYNC();
    MLP(2);
    norm_phase(h, a.in[23], XN, gw, NGW, lane);
    cvt_mat(a.in[24], D, NSA_W, NSA_PAD, WMIX, D, 0, 0, scr, gw, NGW, lane);
#define NSA_AUX(FB, NWV) do { \
        cvt_mat<FB>(a.in[31], D, D, D, (bf16_t*)(ws + WS_WMIX + WM_NSA_WO), D, 0, 0, scr, gw, (NWV), lane); \
        cvt_mat<FB>(a.in[26], 2048, 256, 256, (bf16_t*)(ws + WS_WMIX + WM_NSA_C1K), 2048, 0, 0, scr, gw, (NWV), lane); \
        cvt_mat<FB>(a.in[29], 2048, 256, 256, (bf16_t*)(ws + WS_WMIX + WM_NSA_C1V), 2048, 0, 0, scr, gw, (NWV), lane); \
        cvt_mat<FB>(a.in[27], 256, 64, 256, (bf16_t*)(ws + WS_WMIX + WM_NSA_C2K), 256, 0, 0, scr, gw, (NWV), lane); \
        cvt_mat<FB>(a.in[30], 256, 64, 256, (bf16_t*)(ws + WS_WMIX + WM_NSA_C2V), 256, 0, 0, scr, gw, (NWV), lane); \
        { const int gwx = gw - (FB) * 8;     \
          if (gwx >= 0 && gwx < 512) { const int which = gwx >> 8, c = gwx & 255; const float* pe = a.in[which ? 28 : 25]; const float* w1 = a.in[which ? 29 : 26]; float sacc = 0.f; \
            _Pragma("unroll") for (int kk = 0; kk < 32; ++kk) { const int k = lane + 64 * kk; sacc += pe[k] * w1[(size_t)k * 256 + c]; } \
            sacc = wave_sum(sacc); if (lane == 0) ((float*)(ws + WS_CB))[gwx] = sacc; } } \
        { const int g_ = GTID() - (FB) * 512;     \
          if (g_ >= 0 && g_ < 1024) { ((unsigned*)(ws + WS_KCR + (size_t)4 * S * 64 * 2))[g_] = 0u; ((unsigned*)(ws + WS_VCR + (size_t)4 * S * 64 * 2))[g_] = 0u; } } \
    } while (0)
    if (G != 256) { NSA_AUX(0, NGW); CVT_MLP(33, 34); }
    GSYNC();
    { pg8::EpiNSA E_{(bf16_t*)(ws + WS_NQ), (bf16_t*)(ws + WS_KCR), (bf16_t*)(ws + WS_VCR), (bf16_t*)(ws + WS_KSL), (bf16_t*)(ws + WS_VST), (bf16_t*)(ws + WS_KWN), (bf16_t*)(ws + WS_VWN), (float*)(ws + WS_GAT), cosT, sinT};
      GEMM(pg8::EpiNSA, E_, XN, WMIX, S, NSA_PAD, D, D, 0, true, bid); }
    if (G == 256) NSA_AUX(192, 64 * 8);
    GSYNC();
    { pg8::EpiCmp E_{(bf16_t*)(ws + WS_CH), (const float*)(ws + WS_CB)}; GEMM(pg8::EpiCmp, E_, ws + WS_KCR, ws + WS_WMIX + WM_NSA_C1K, 4096, 256, 2048, 1024, 0, false, bid); }
    { pg8::EpiCmp E_{(bf16_t*)(ws + WS_CH) + 4096 * 256, (const float*)(ws + WS_CB) + 256}; GEMM(pg8::EpiCmp, E_, ws + WS_VCR, ws + WS_WMIX + WM_NSA_C1V, 4096, 256, 2048, 1024, 0, false, (bid + G / 2) % G); }
    if (G == 256) { cvt_mat<144>(a.in[33], D, FF, FF, W1T, D, 0, 0, scr, gw, 112 * 8, lane); cvt_mat<144>(a.in[34], FF, D, D, W2T, FF, 0, 0, scr, gw, 112 * 8, lane); }
    GSYNC();
    { pg8::EpiCmp2<true> E_{(bf16_t*)(ws + WS_KC), cosT, sinT}; GEMM(pg8::EpiCmp2<true>, E_, ws + WS_CH, ws + WS_WMIX + WM_NSA_C2K, 4096, 256, 256, 256, 0, false, bid); }
    { pg8::EpiCmp2<false> E_{(bf16_t*)(ws + WS_VC), cosT, sinT}; GEMM(pg8::EpiCmp2<false>, E_, (bf16_t*)(ws + WS_CH) + 4096 * 256, ws + WS_WMIX + WM_NSA_C2V, 4096, 256, 256, 256, 0, false, (bid + G / 2) % G); }
    GSYNC();
    for (int qn = 0; qn < 4; ++qn) {
        const int kvh = (((bid & 7) >> 1) + qn) & 3;
        for (;;) {
            __syncthreads();
            if (tid == 0) *(volatile LAS unsigned*)(lds + ATT_MISC + 64) = atomicAdd((unsigned*)(ws + WS_BAR + 15 * 1024 + 64 + 64 * kvh), 1u);
            __syncthreads();
            const unsigned u = *(volatile LAS unsigned*)(lds + ATT_MISC + 64);
            if (u >= 256u) break;
            nsa_cs_unit(lds, kvh, 255 - (int)u, (const bf16_t*)(ws + WS_NQ), (const bf16_t*)(ws + WS_KC), (const bf16_t*)(ws + WS_VC), (const bf16_t*)(ws + WS_KSL), (const bf16_t*)(ws + WS_VST), (const bf16_t*)(ws + WS_KWN), (const bf16_t*)(ws + WS_VWN), (const float*)(ws + WS_GAT), (bf16_t*)(ws + WS_O3), tid, lane, wid);
        }
    }
    __syncthreads();
    GSYNC();
    { pg8::EpiRes E_{h, h, nullptr}; GEMM(pg8::EpiRes, E_, ws + WS_O3, ws + WS_WMIX + WM_NSA_WO, S, D, D, D, 0, false, bid); }
    GSYNC();
    norm_phase(h, a.in[32], XN, gw, NGW, lane);
    GSYNC();
    MLP(3);
    final_norm_phase(h, a.in[35], gw, NGW, lane);
    if (a.ws == nullptr) cg::this_grid().sync();
}

extern "C" void kernel_launch(void* const* d_in, const int* in_sizes, int n_in, void* d_out, int out_size, void* d_ws, size_t ws_size, hipStream_t stream) {
    static int grid = 0;
    if (grid == 0) {
        if (n_in != 36 || out_size != S * D || ws_size < WS_END) { fprintf(stderr, "kernel_launch: unexpected shapes (n_in %d out %d ws %zu)\n", n_in, out_size, ws_size); grid = -1; return; }
        int dev = 0, cus = 0, per_cu = 0;
        hipGetDevice(&dev); hipDeviceGetAttribute(&cus, hipDeviceAttributeMultiprocessorCount, dev);
        if (hipFuncSetAttribute((const void*)mega_fwd, hipFuncAttributeMaxDynamicSharedMemorySize, LDS_BYTES) != hipSuccess) { fprintf(stderr, "kernel_launch: hipFuncSetAttribute failed\n"); grid = -1; return; }
        if (hipOccupancyMaxActiveBlocksPerMultiprocessor(&per_cu, (const void*)mega_fwd, 512, LDS_BYTES) != hipSuccess || per_cu < 1) per_cu = 1;
        (void)hipGetLastError();
        grid = cus * (per_cu > 1 ? 1 : per_cu);
    }
    if (grid < 0) return;
    if (hipMemsetAsync((unsigned char*)d_ws + WS_BAR, 0, 16384, stream) != hipSuccess) { fprintf(stderr, "kernel_launch: memset failed\n"); return; }
    Args a{};
    for (int i = 0; i < 36; ++i) a.in[i] = (const float*)d_in[i];
    a.out = (float*)d_out; a.ws = (unsigned char*)d_ws;
    void* args[] = {&a};
    hipError_t e = hipLaunchCooperativeKernel((const void*)mega_fwd, dim3(grid), dim3(512), args, LDS_BYTES, stream);
    if (e != hipSuccess) fprintf(stderr, "cooperative launch failed: %s (grid %d)\n", hipGetErrorString(e), grid);
}
```

```cpp
#include <hip/hip_runtime.h>
#include <hip/hip_cooperative_groups.h>
#include <cstdio>
#include <cstdint>
namespace cg = cooperative_groups;

#define LAS __attribute__((address_space(3)))
typedef unsigned short bf16_t;
typedef short bf16x8 __attribute__((ext_vector_type(8)));
typedef short s16x4 __attribute__((ext_vector_type(4)));
typedef float f32x2 __attribute__((ext_vector_type(2)));
typedef float f32x4 __attribute__((ext_vector_type(4)));
typedef float f32x16 __attribute__((ext_vector_type(16)));
typedef unsigned u32x2 __attribute__((ext_vector_type(2)));
typedef unsigned u32x4 __attribute__((ext_vector_type(4)));
typedef LAS unsigned char* ldsp;

constexpr int S = 16384, D = 1024, FF = 4096, NH = 16, HD = 64;
constexpr int NQKV_PAD = 3328;
constexpr int NSA_W = 2608, NSA_PAD = 2816;
constexpr int NCMP = 1023;
constexpr float RMS_EPS = 1e-6f;
constexpr float NEGF = -1e30f;
constexpr float LOG2E = 1.4426950408889634f;
constexpr float C2 = 0.125f * 1.4426950408889634f;

constexpr size_t MiB = 1u << 20;
constexpr size_t WS_HID = 0;
constexpr size_t WS_XN = 128 * MiB;
constexpr size_t WS_W1T = 160 * MiB;
constexpr size_t WS_W2T = 168 * MiB;
constexpr size_t WS_WMIX = 176 * MiB;
constexpr size_t WS_MISC = 190 * MiB;
constexpr size_t WS_END = 256 * MiB;
constexpr size_t WS_FQ = 0, WS_FK = 32 * MiB, WS_FV = 64 * MiB, WS_FO = 96 * MiB;
constexpr size_t WS_LF = WS_MISC;
constexpr size_t WS_KMAX = WS_MISC + 2 * MiB;
constexpr size_t WS_PD = 0;
constexpr size_t WS_BCU = 0;
constexpr size_t WS_CY = 96 * MiB;
constexpr size_t WS_NQ = 0;
constexpr size_t WS_O3 = 32 * MiB;
constexpr size_t NSA_KV_STRIDE = 9 * MiB;
constexpr size_t WS_KCR = 190 * MiB, WS_VCR = 199 * MiB, WS_KSL = 208 * MiB, WS_VST = 217 * MiB, WS_KWN = 226 * MiB, WS_VWN = 235 * MiB;
constexpr size_t WS_GAT = 244 * MiB;
constexpr size_t WS_CH = 247 * MiB;
constexpr size_t WS_KC = 255 * MiB;
constexpr size_t WS_VC = 255 * MiB + 512 * 1024;
constexpr size_t WS_COS = 198 * MiB + 64 * 1024;
constexpr size_t WS_SIN = 207 * MiB + 64 * 1024;
constexpr size_t WS_BAR = 198 * MiB + 16 * 1024;
constexpr size_t WS_CB = 216 * MiB + 64 * 1024;
constexpr size_t WM_A = 0;
constexpr size_t WM_B = 7 * MiB;
constexpr size_t WM_C = 13 * MiB;
constexpr size_t WM_NSA_IN = 0, WM_NSA_WO = 6 * MiB, WM_NSA_C1K = 12 * MiB, WM_NSA_C1V = 13 * MiB, WM_NSA_C2K = 5 * MiB + 512 * 1024, WM_NSA_C2V = 5 * MiB + 768 * 1024;

constexpr int LDS_BYTES = 147456;
constexpr int ATT_BUF = 0;
constexpr int ATT_WSF = 32768;
constexpr int ATT_OST = 34816;
constexpr int ATT_BIG = 67584;
constexpr int ATT_SEL = 133120;
constexpr int ATT_MISC = 137216;
constexpr int LDS_XB = 147392;

typedef __bf16 bf16x2_t __attribute__((ext_vector_type(2)));
__device__ __forceinline__ unsigned pk2(float lo, float hi) { const f32x2 v = {lo, hi}; const bf16x2_t b = __builtin_convertvector(v, bf16x2_t); return __builtin_bit_cast(unsigned, b); }
__device__ __forceinline__ unsigned f2bf(float f) { return pk2(f, 0.f) & 0xffffu; }
__device__ __forceinline__ float bf2f(unsigned short b) { return __builtin_bit_cast(float, (unsigned)b << 16); }
__device__ __forceinline__ float wave_sum(float v) {
#pragma unroll
    for (int o = 1; o < 64; o <<= 1) v += __shfl_xor(v, o);
    return v;
}
__device__ __forceinline__ int fresh_tid() { int t = threadIdx.x; asm volatile("" : "+v"(t)); return t; }
__device__ __forceinline__ float ex2(float x) { return __builtin_amdgcn_exp2f(x); }
__device__ __forceinline__ long pk8_fp8(float a0, float a1, float a2, float a3, float a4, float a5, float a6, float a7) {
    int w0 = __builtin_amdgcn_cvt_pk_fp8_f32(a0, a1, 0, false); w0 = __builtin_amdgcn_cvt_pk_fp8_f32(a2, a3, w0, true);
    int w1 = __builtin_amdgcn_cvt_pk_fp8_f32(a4, a5, 0, false); w1 = __builtin_amdgcn_cvt_pk_fp8_f32(a6, a7, w1, true);
    return (long)(((unsigned long long)(unsigned)w1 << 32) | (unsigned long long)(unsigned)w0);
}
__device__ __forceinline__ float xmax16(float x) { const unsigned b = __builtin_bit_cast(unsigned, x); auto r = __builtin_amdgcn_permlane16_swap(b, b, false, false); return fmaxf(__builtin_bit_cast(float, r[0]), __builtin_bit_cast(float, r[1])); }
__device__ __forceinline__ float xmax32(float x) { const unsigned b = __builtin_bit_cast(unsigned, x); auto r = __builtin_amdgcn_permlane32_swap(b, b, false, false); return fmaxf(__builtin_bit_cast(float, r[0]), __builtin_bit_cast(float, r[1])); }
__device__ __forceinline__ float dpp_xor1(float v) { return __builtin_bit_cast(float, __builtin_amdgcn_update_dpp(0, __builtin_bit_cast(int, v), 0xB1, 0xF, 0xF, true)); }
__device__ __forceinline__ float dpp_xor2(float v) { return __builtin_bit_cast(float, __builtin_amdgcn_update_dpp(0, __builtin_bit_cast(int, v), 0x4E, 0xF, 0xF, true)); }
__device__ __forceinline__ int crow(int r, int hi) { return (r & 3) + 8 * (r >> 2) + 4 * hi; }

namespace pg8 {
constexpr int BM = 256, BK = 64, HALF = 128, HTB = HALF * BK * 2, STAGE_BYTES = 8 * HTB, NXCD = 8, WGM = 4;
__device__ __forceinline__ int lds_byte(int r, int c) { const int st = (r >> 4) * 2 + (c >> 5), rr = r & 15, cc = c & 31, ob = rr * 64 + cc * 2; return st * 1024 + (ob ^ (((ob >> 9) & 1) << 5)); }
__device__ __forceinline__ void stage_rc(int b, int& R, int& C) { const int st = b / 1024, sb = b % 1024, swz = sb ^ (((sb >> 9) & 1) << 5); R = (st >> 1) * 16 + swz / 64; C = (st & 1) * 32 + (swz % 64) / 2; }
__device__ __forceinline__ int perm32(int rho) { const int n = rho >> 4, i = rho & 15; return 8 * (i >> 2) + 4 * n + (i & 3); }

struct Unit { int pm, pn; };
struct Gemm { const bf16_t* A; const bf16_t* Bt; int M, N, K; int lda; size_t a_pn_bytes; };

struct StaticOrder {
    int nM, nN, nwg, G, c;
    __device__ void init(int M, int N, int G_, int c_) { nM = M / BM; nN = N / BM; nwg = nM * nN; G = G_; c = c_; }
    __device__ bool next(int i, Unit& u) const {
        const long L = (long)i * G + c; if (L >= nwg) return false;
        int wgid = (int)L; { const int q = nwg / NXCD, r = nwg % NXCD, xcd = wgid % NXCD, off = wgid / NXCD; wgid = (xcd < r ? xcd * (q + 1) : r * (q + 1) + (xcd - r) * q) + off; }
        const int nig = WGM * nN, gid = wgid / nig, fm = gid * WGM, gsz = (nM - fm) < WGM ? (nM - fm) : WGM;
        u.pm = fm + ((wgid % nig) % gsz); u.pn = (wgid % nig) / gsz; return true;
    }
};

template <class Epi, bool ALIGN_EPI>
__device__ __forceinline__ void gemm_phase(ldsp lds, const Gemm g, const StaticOrder& S, const Epi& E) {
    int tid = threadIdx.x; asm volatile("" : "+v"(tid));
    const int wid = __builtin_amdgcn_readfirstlane(tid >> 6), lane = tid & 63, wr = wid >> 2, wc = wid & 3, fr = lane & 15, fq = lane >> 4;
    const int K = g.K, nt = K / BK;
    unsigned voffA[2], voffB[2];
#pragma unroll
    for (int i = 0; i < 2; ++i) { int R, C; stage_rc(tid * 16 + i * 8192, R, C); const int Rb = Epi::PERM ? ((R & ~31) + perm32(R & 31)) : R;
        voffA[i] = (unsigned)(R * g.lda + C) * 2u; voffB[i] = (unsigned)(Rb * K + C) * 2u; }
    const size_t kstep = (size_t)(BK * 2);
    const size_t hstepA = (size_t)HALF * g.lda * 2, hstepB = (size_t)HALF * K * 2;
    const size_t tstepA = 2 * hstepA, tstepB = 2 * hstepB;
    const unsigned ldsw = (unsigned)wid * 1024u;
    const int aoff = lds_byte(wr * 64 + fr, fq * 8), boff = lds_byte(wc * 32 + fr, fq * 8);
#define PG8_SA(b, h) (((b) * 2 + (h)) * HTB)
#define PG8_SB(b, h) ((4 + (b) * 2 + (h)) * HTB)
#define PG8_STAGE(bufoff, gbase, voff) do { _Pragma("unroll") for (int _i = 0; _i < 2; ++_i) \
        __builtin_amdgcn_global_load_lds((const unsigned*)((const char*)(gbase) + (voff)[_i]), (LAS unsigned*)(lds + (bufoff) + ldsw + _i * 8192), 16, 0, 0); } while (0)
#define PG8_LDA(dst, b, h) do { _Pragma("unroll") for (int m = 0; m < 4; ++m) _Pragma("unroll") for (int k = 0; k < 2; ++k) dst[m][k] = *(const LAS bf16x8*)(lds + PG8_SA(b, h) + aoff + m * 2048 + k * 1024); } while (0)
#define PG8_LDB(dst, b, h) do { _Pragma("unroll") for (int n = 0; n < 2; ++n) _Pragma("unroll") for (int k = 0; k < 2; ++k) dst[n][k] = *(const LAS bf16x8*)(lds + PG8_SB(b, h) + boff + n * 2048 + k * 1024); } while (0)
#define PG8_MMA(ai, bj, At, Bt) do { __builtin_amdgcn_s_setprio(1); _Pragma("unroll") for (int m = 0; m < 4; ++m) _Pragma("unroll") for (int n = 0; n < 2; ++n) _Pragma("unroll") for (int k = 0; k < 2; ++k) \
        acc[ai][bj][m][n] = __builtin_amdgcn_mfma_f32_16x16x32_bf16(Bt[n][k], At[m][k], acc[ai][bj][m][n], 0, 0, 0); __builtin_amdgcn_s_setprio(0); } while (0)
#define PG8_WAIT_V(n) asm volatile("s_waitcnt vmcnt(" #n ")" ::: "memory")
#define PG8_WAIT_L(n) asm volatile("s_waitcnt lgkmcnt(" #n ")" ::: "memory")
#define PG8_BAR __builtin_amdgcn_s_barrier()
#define PG8_SCHED __builtin_amdgcn_sched_barrier(0)
    Unit cur, nxt; int ui = 0;
    if (!S.next(0, cur)) return;
    f32x4 acc[2][2][4][2];
#pragma unroll
    for (int a = 0; a < 2; ++a)
#pragma unroll
        for (int b = 0; b < 2; ++b)
#pragma unroll
            for (int m = 0; m < 4; ++m)
#pragma unroll
                for (int n = 0; n < 2; ++n) acc[a][b][m][n] = (f32x4){0.f, 0.f, 0.f, 0.f};
    bf16x8 At[4][2], B0[2][2], B1[2][2];
    const char* cA = (const char*)g.A + (size_t)cur.pm * tstepA + (size_t)cur.pn * g.a_pn_bytes; const char* cB = (const char*)g.Bt + (size_t)cur.pn * tstepB;
    PG8_STAGE(PG8_SB(0, 0), cB, voffB); PG8_STAGE(PG8_SB(0, 1), cB + hstepB, voffB); PG8_STAGE(PG8_SA(0, 0), cA, voffA); PG8_STAGE(PG8_SA(0, 1), cA + hstepA, voffA);
    if (wr == 1) PG8_BAR;
    PG8_WAIT_V(2); PG8_BAR;
    PG8_STAGE(PG8_SB(1, 0), cB + kstep, voffB); PG8_STAGE(PG8_SA(1, 0), cA + kstep, voffA); PG8_STAGE(PG8_SB(1, 1), cB + hstepB + kstep, voffB);
    PG8_WAIT_V(6); PG8_BAR;
    for (;;) {
        const bool has_next = S.next(ui + 1, nxt);
        const char* nA = has_next ? (const char*)g.A + (size_t)nxt.pm * tstepA + (size_t)nxt.pn * g.a_pn_bytes : cA; const char* nB = has_next ? (const char*)g.Bt + (size_t)nxt.pn * tstepB : cB;
        for (int t = 0; t < nt; t += 2) {
            const bool last = (t == nt - 2);
            const char* a1 = cA + (size_t)(t + 1) * kstep;
            const char* a2 = last ? nA : cA + (size_t)(t + 2) * kstep; const char* b2 = last ? nB : cB + (size_t)(t + 2) * kstep;
            const char* a3 = a2 + kstep; const char* b3 = b2 + kstep;
            PG8_LDB(B0, 0, 0); PG8_LDB(B1, 0, 1); PG8_SCHED; PG8_LDA(At, 0, 0); PG8_STAGE(PG8_SA(1, 1), a1 + hstepA, voffA);
            PG8_WAIT_V(8); PG8_WAIT_L(0); PG8_BAR; PG8_MMA(0, 0, At, B0); PG8_MMA(0, 1, At, B1); PG8_BAR; PG8_SCHED;
            PG8_LDA(At, 0, 1); PG8_STAGE(PG8_SB(0, 0), b2, voffB); PG8_STAGE(PG8_SB(0, 1), b2 + hstepB, voffB); PG8_STAGE(PG8_SA(0, 0), a2, voffA);
            PG8_WAIT_V(8); PG8_WAIT_L(0); PG8_BAR; PG8_MMA(1, 0, At, B0); PG8_MMA(1, 1, At, B1); PG8_BAR; PG8_SCHED;
            PG8_LDB(B0, 1, 0); PG8_LDB(B1, 1, 1); PG8_SCHED; PG8_LDA(At, 1, 0); PG8_STAGE(PG8_SA(0, 1), a2 + hstepA, voffA);
            PG8_WAIT_V(8); PG8_WAIT_L(0); PG8_BAR; PG8_MMA(0, 0, At, B0); PG8_MMA(0, 1, At, B1); PG8_BAR; PG8_SCHED;
            PG8_LDA(At, 1, 1); PG8_STAGE(PG8_SB(1, 0), b3, voffB); PG8_STAGE(PG8_SB(1, 1), b3 + hstepB, voffB); PG8_STAGE(PG8_SA(1, 0), a3, voffA);
            PG8_WAIT_V(8); PG8_WAIT_L(0); PG8_BAR; PG8_MMA(1, 0, At, B0); PG8_MMA(1, 1, At, B1); PG8_BAR; PG8_SCHED;
        }
        if constexpr (ALIGN_EPI) { if (wr == 0) PG8_BAR; }
        E(acc, cur, wr, wc, fr, fq);
        if (!has_next) break;
#pragma unroll
        for (int a = 0; a < 2; ++a)
#pragma unroll
            for (int b = 0; b < 2; ++b)
#pragma unroll
                for (int m = 0; m < 4; ++m)
#pragma unroll
                    for (int n = 0; n < 2; ++n) acc[a][b][m][n] = (f32x4){0.f, 0.f, 0.f, 0.f};
        cur = nxt; cA = nA; cB = nB; ++ui;
        if constexpr (ALIGN_EPI) { if (wr == 1) PG8_BAR; }
    }
    PG8_WAIT_V(0);
    if constexpr (!ALIGN_EPI) { if (wr == 0) PG8_BAR; }
    PG8_BAR;
#undef PG8_SA
#undef PG8_SB
#undef PG8_STAGE
#undef PG8_LDA
#undef PG8_LDB
#undef PG8_MMA
#undef PG8_WAIT_V
#undef PG8_WAIT_L
#undef PG8_BAR
#undef PG8_SCHED
}

typedef f32x4 Acc[2][2][4][2];

template <int ACT  > struct EpiBf16 {
    static constexpr bool PERM = true;
    bf16_t* O; int ldc;
    __device__ __forceinline__ void operator()(const Acc& acc, const Unit& u, int wr, int wc, int fr, int fq) const {
        const int row0 = u.pm * BM + wr * 64 + fr, col0 = u.pn * BM + wc * 32 + 8 * fq;
#pragma unroll
        for (int ai = 0; ai < 2; ++ai)
#pragma unroll
            for (int m = 0; m < 4; ++m) { bf16_t* rowp = O + (size_t)(row0 + ai * HALF + m * 16) * ldc + col0;
#pragma unroll
                for (int bj = 0; bj < 2; ++bj) { f32x4 v0 = acc[ai][bj][m][0], v1 = acc[ai][bj][m][1];
                    if (ACT == 1) {
#pragma unroll
                        for (int e = 0; e < 4; ++e) { float a = fmaxf(v0[e], 0.f), b = fmaxf(v1[e], 0.f); v0[e] = a * a; v1[e] = b * b; } }
                    u32x4 w; w.x = pk2(v0[0], v0[1]); w.y = pk2(v0[2], v0[3]); w.z = pk2(v1[0], v1[1]); w.w = pk2(v1[2], v1[3]);
                    *(u32x4*)(rowp + bj * HALF) = w; } }
    }
};

struct EpiRes {
    static constexpr bool PERM = false;
    const float* base; float* out; const float* cs;
    __device__ __forceinline__ void operator()(const Acc& acc, const Unit& u, int wr, int wc, int fr, int fq) const {
        const int col0 = u.pn * BM + wc * 32 + 4 * fq;
        f32x4 csv[2][2];
#pragma unroll
        for (int bj = 0; bj < 2; ++bj)
#pragma unroll
            for (int n = 0; n < 2; ++n) csv[bj][n] = cs ? *(const f32x4*)(cs + col0 + bj * HALF + n * 16) : (f32x4){1.f, 1.f, 1.f, 1.f};
#pragma unroll
        for (int ai = 0; ai < 2; ++ai) {
            f32x4 pre[4][2][2];
#pragma unroll
            for (int m = 0; m < 4; ++m) { const size_t off = (size_t)(u.pm * BM + ai * HALF + wr * 64 + m * 16 + fr) * D + col0;
#pragma unroll
                for (int bj = 0; bj < 2; ++bj)
#pragma unroll
                    for (int n = 0; n < 2; ++n) pre[m][bj][n] = *(const f32x4*)(base + off + bj * HALF + n * 16); }
#pragma unroll
            for (int m = 0; m < 4; ++m) { const size_t off = (size_t)(u.pm * BM + ai * HALF + wr * 64 + m * 16 + fr) * D + col0;
#pragma unroll
                for (int bj = 0; bj < 2; ++bj)
#pragma unroll
                    for (int n = 0; n < 2; ++n) *(f32x4*)(out + off + bj * HALF + n * 16) = pre[m][bj][n] + acc[ai][bj][m][n] * csv[bj][n]; }
        }
    }
};

__device__ __forceinline__ float logsigmoid(float x) { return fminf(x, 0.f) - log1pf(expf(-fabsf(x))); }

struct EpiQKV {
    static constexpr bool PERM = true;
    bf16_t* Q; bf16_t* Kb; bf16_t* Vb; float* lf; const float* bfg; unsigned* kmax;
    __device__ __forceinline__ void operator()(const Acc& acc, const Unit& u, int wr, int wc, int fr, int fq) const {
        const int row0 = u.pm * BM + wr * 64 + fr;
        if (u.pn >= 4 && u.pn < 8) {
            float mx[2] = {0.f, 0.f};
#pragma unroll
            for (int ai = 0; ai < 2; ++ai)
#pragma unroll
                for (int m = 0; m < 4; ++m)
#pragma unroll
                    for (int bj = 0; bj < 2; ++bj) { const f32x4 v0 = acc[ai][bj][m][0], v1 = acc[ai][bj][m][1];
                        float s2 = (v0[0] * v0[0] + v0[1] * v0[1]) + (v0[2] * v0[2] + v0[3] * v0[3]) + (v1[0] * v1[0] + v1[1] * v1[1]) + (v1[2] * v1[2] + v1[3] * v1[3]);
                        s2 += __shfl_xor(s2, 16); s2 += __shfl_xor(s2, 32); mx[bj] = fmaxf(mx[bj], s2); }
#pragma unroll
            for (int bj = 0; bj < 2; ++bj) { float v = mx[bj];
#pragma unroll
                for (int o = 1; o < 16; o <<= 1) v = fmaxf(v, __shfl_xor(v, o));
                if ((threadIdx.x & 63) == 0) atomicMax(kmax + (((u.pn - 4) * 4 + bj * 2 + (wc >> 1)) * 2 + (wc & 1)), __builtin_bit_cast(unsigned, v * 1.02f)); }
        }
        if (u.pn < 12) {
            const int t = u.pn >> 2; bf16_t* base = Q + (size_t)t * ((size_t)S * D); const float sc = t == 0 ? C2 : 1.f;
            const int col0 = (u.pn & 3) * BM + wc * 32 + 8 * fq;
#pragma unroll
            for (int ai = 0; ai < 2; ++ai)
#pragma unroll
                for (int m = 0; m < 4; ++m) { bf16_t* rowp = base + (size_t)(row0 + ai * HALF + m * 16) * D + col0;
#pragma unroll
                    for (int bj = 0; bj < 2; ++bj) { const f32x4 v0 = acc[ai][bj][m][0] * sc, v1 = acc[ai][bj][m][1] * sc;
                        u32x4 w; w.x = pk2(v0[0], v0[1]); w.y = pk2(v0[2], v0[3]); w.z = pk2(v1[0], v1[1]); w.w = pk2(v1[2], v1[3]);
                        *(u32x4*)(rowp + bj * HALF) = w; } }
        } else if (wc == 0 && fq < 2) {
#pragma unroll
            for (int ai = 0; ai < 2; ++ai)
#pragma unroll
                for (int m = 0; m < 4; ++m) { const int row = row0 + ai * HALF + m * 16;
#pragma unroll
                    for (int n = 0; n < 2; ++n)
#pragma unroll
                        for (int e = 0; e < 4; ++e) { const int head = 8 * fq + 4 * n + e; lf[(size_t)head * S + row] = logsigmoid(acc[ai][0][m][n][e] + bfg[head]); } }
        }
    }
};

struct EpiNSA {
    static constexpr bool PERM = true;
    bf16_t* Q; bf16_t* kcr; bf16_t* vcr; bf16_t* ksl; bf16_t* vst; bf16_t* kwn; bf16_t* vwn; float* gates; const float* cosT; const float* sinT;
    __device__ __forceinline__ void operator()(const Acc& acc, const Unit& u, int wr, int wc, int fr, int fq) const {
        const int row0 = u.pm * BM + wr * 64 + fr; const int pn = u.pn;
        if (pn == 10) {
            if (wc < 2) {
#pragma unroll
                for (int ai = 0; ai < 2; ++ai)
#pragma unroll
                    for (int m = 0; m < 4; ++m) { const int row = row0 + ai * HALF + m * 16; const int c0 = wc * 32 + 8 * fq;
                        if (c0 < 48) {
#pragma unroll
                            for (int n = 0; n < 2; ++n) { f32x4 v = acc[ai][0][m][n];
#pragma unroll
                                for (int e = 0; e < 4; ++e) v[e] = 1.f / (1.f + expf(-v[e]));
                                *(f32x4*)(gates + (size_t)row * 48 + c0 + 4 * n) = v; } } }
            }
            return;
        }
        const bool do_rope = (pn < 4 || pn == 6 || pn == 8) && ((wc & 1) == 0);
        const float sc = pn < 4 ? C2 : 1.f;
#pragma unroll
        for (int ai = 0; ai < 2; ++ai)
#pragma unroll
            for (int m = 0; m < 4; ++m) { const int row = row0 + ai * HALF + m * 16;
                f32x4 cs0 = {1.f, 1.f, 1.f, 1.f}, cs1 = cs0, sn0 = {0.f, 0.f, 0.f, 0.f}, sn1 = sn0;
                if (do_rope) { cs0 = *(const f32x4*)(cosT + (size_t)row * 8); cs1 = *(const f32x4*)(cosT + (size_t)row * 8 + 4); sn0 = *(const f32x4*)(sinT + (size_t)row * 8); sn1 = *(const f32x4*)(sinT + (size_t)row * 8 + 4); }
#pragma unroll
                for (int bj = 0; bj < 2; ++bj) { f32x4 v0 = acc[ai][bj][m][0], v1 = acc[ai][bj][m][1];
                    if (do_rope) { f32x4 p0, p1;
#pragma unroll
                        for (int e = 0; e < 4; ++e) { p0[e] = __shfl_xor(v0[e], 16); p1[e] = __shfl_xor(v1[e], 16); }
                        if (fq == 0) { v0 = v0 * cs0 - p0 * sn0; v1 = v1 * cs1 - p1 * sn1; }
                        else if (fq == 1) { v0 = v0 * cs0 + p0 * sn0; v1 = v1 * cs1 + p1 * sn1; } }
                    v0 = v0 * sc; v1 = v1 * sc;
                    const int cl = bj * HALF + wc * 32 + 8 * fq;
                    if (pn < 4) { u32x4 w; w.x = pk2(v0[0], v0[1]); w.y = pk2(v0[2], v0[3]); w.z = pk2(v1[0], v1[1]); w.w = pk2(v1[2], v1[3]);
                        *(u32x4*)(Q + (size_t)row * D + pn * BM + cl) = w; }
                    else if (pn == 6) { const int kvh = cl >> 6, d0 = cl & 63;
                        *(long*)((unsigned char*)ksl + ((size_t)kvh * S + row) * 64 + d0) = pk8_fp8(v0[0], v0[1], v0[2], v0[3], v1[0], v1[1], v1[2], v1[3]); }
                    else if (pn == 7) { const int kvh = cl >> 6, d0 = cl & 63; const int blk = row >> 6, kk = row & 63;
                        const int g4 = kk >> 4, mgk = (kk >> 2) & 3, rr = kk & 3; const int slot = 16 * mgk + 8 * (g4 >> 1) + 4 * (g4 & 1) + rr;
                        unsigned char* dst = (unsigned char*)vst + ((size_t)(kvh * 256 + blk) * 64 + d0) * 64 + slot;
                        const long pk = pk8_fp8(v0[0], v0[1], v0[2], v0[3], v1[0], v1[1], v1[2], v1[3]);
#pragma unroll
                        for (int e = 0; e < 8; ++e) dst[(size_t)e * 64] = (unsigned char)((unsigned long long)pk >> (8 * e)); }
                    else { bf16_t* base = (bf16_t*)((unsigned char*)kcr + (size_t)(pn - 4) * NSA_KV_STRIDE);
                        const int kvh = cl >> 6, d0 = cl & 63;
                        u32x4 w; w.x = pk2(v0[0], v0[1]); w.y = pk2(v0[2], v0[3]); w.z = pk2(v1[0], v1[1]); w.w = pk2(v1[2], v1[3]);
                        *(u32x4*)(base + ((size_t)kvh * S + row) * 64 + d0) = w; } } }
    }
};

struct EpiCmp {
    static constexpr bool PERM = false;
    bf16_t* O; const float* bias;
    __device__ __forceinline__ void operator()(const Acc& acc, const Unit& u, int wr, int wc, int fr, int fq) const {
        const int col0 = u.pn * BM + wc * 32 + 4 * fq;
#pragma unroll
        for (int ai = 0; ai < 2; ++ai)
#pragma unroll
            for (int m = 0; m < 4; ++m) { const size_t off = (size_t)(u.pm * BM + ai * HALF + wr * 64 + m * 16 + fr) * 256 + col0;
#pragma unroll
                for (int bj = 0; bj < 2; ++bj)
#pragma unroll
                    for (int n = 0; n < 2; ++n) { const int o2 = bj * HALF + n * 16; f32x4 a = acc[ai][bj][m][n] + *(const f32x4*)(bias + col0 + o2);
#pragma unroll
                        for (int e = 0; e < 4; ++e) { const float x = a[e]; a[e] = 0.5f * x * (1.f + tanhf(0.7978845608028654f * (x + 0.044715f * x * x * x))); }
                        u32x2 w; w.x = pk2(a[0], a[1]); w.y = pk2(a[2], a[3]); *(u32x2*)(O + off + o2) = w; } }
    }
};
template <bool ROPE> struct EpiCmp2 {
    static constexpr bool PERM = false;
    bf16_t* O; const float* cosT; const float* sinT;
    __device__ __forceinline__ void operator()(const Acc& acc, const Unit& u, int wr, int wc, int fr, int fq) const {
        if (wc >= 2) return;
#pragma unroll
        for (int ai = 0; ai < 2; ++ai)
#pragma unroll
            for (int m = 0; m < 4; ++m) { const int row = u.pm * BM + ai * HALF + wr * 64 + m * 16 + fr; const int nr = row & 1023;
#pragma unroll
                for (int n = 0; n < 2; ++n) { f32x4 v = acc[ai][0][m][n];
                    if (ROPE && n == 0 && wc == 0) { const int pe_ = 16 * nr + 31; const int pidx = pe_ < S ? pe_ : S - 1;
                        const f32x4 c = *(const f32x4*)(cosT + (size_t)pidx * 8 + 4 * (fq & 1)), sn = *(const f32x4*)(sinT + (size_t)pidx * 8 + 4 * (fq & 1)); f32x4 p;
#pragma unroll
                        for (int e = 0; e < 4; ++e) p[e] = __shfl_xor(v[e], 32);
                        v = fq < 2 ? v * c - p * sn : v * c + p * sn; }
                    if (nr >= NCMP) v = (f32x4){0.f, 0.f, 0.f, 0.f};
                    u32x2 w; w.x = pk2(v[0], v[1]); w.y = pk2(v[2], v[3]); *(u32x2*)(O + (size_t)row * 64 + wc * 32 + n * 16 + 4 * fq) = w; } }
    }
};
}

template <int FIRST_BLK = 0>
__device__ __forceinline__ void cvt_mat(const float* W, int K, int N, int Npad, bf16_t* WT, int ldk, int row_off, int col_off, LAS float* scr, int gw_unused, int NGW, int lane_unused) {
    if (FIRST_BLK > 0 && (int)blockIdx.x < FIRST_BLK) return;
    const int ftid = fresh_tid(); const int lane = ftid & 63, wv = __builtin_amdgcn_readfirstlane(ftid >> 6); const int gw = ((int)blockIdx.x - FIRST_BLK) * 8 + wv;
    const int nblk = Npad / 32, nitems = (K / 64) * nblk;
    for (int item = gw; item < nitems; item += NGW) {
        const int kb = item / nblk, nb = item % nblk, k0 = 64 * kb, n0 = 32 * nb;
        const int q4 = lane & 7, nn = n0 + 4 * q4;
        f32x4 wv[8];
#pragma unroll
        for (int i = 0; i < 8; ++i) { const int kk = 8 * i + (lane >> 3); wv[i] = (nn < N) ? *(const f32x4*)(W + (size_t)(k0 + kk) * N + nn) : (f32x4){0.f, 0.f, 0.f, 0.f}; }
#pragma unroll
        for (int i = 0; i < 8; ++i) { const int kk = 8 * i + (lane >> 3);
#pragma unroll
            for (int e = 0; e < 4; ++e) scr[kk * 33 + 4 * q4 + e] = wv[i][e]; }
        asm volatile("s_waitcnt lgkmcnt(0)" ::: "memory");
        const int c = lane & 7;
#pragma unroll
        for (int j = 0; j < 4; ++j) { const int n = (lane >> 3) + 8 * j; const LAS float* s = scr + (8 * c) * 33 + n;
            u32x4 o; o.x = pk2(s[0 * 33], s[1 * 33]); o.y = pk2(s[2 * 33], s[3 * 33]); o.z = pk2(s[4 * 33], s[5 * 33]); o.w = pk2(s[6 * 33], s[7 * 33]);
            *(u32x4*)(WT + (size_t)(row_off + n0 + n) * ldk + col_off + k0 + 8 * c) = o; }
        asm volatile("s_waitcnt lgkmcnt(0)" ::: "memory");
    }
}

__device__ __forceinline__ void norm_phase(const float* h, const float* gain, bf16_t* xn, int gw_unused, int NGW, int lane_unused) {
    const int ftid = fresh_tid(); const int lane = ftid & 63; const int gw = blockIdx.x * 8 + __builtin_amdgcn_readfirstlane(ftid >> 6);
    f32x4 g[4];
#pragma unroll
    for (int j = 0; j < 4; ++j) g[j] = ((const f32x4*)gain)[lane + 64 * j];
    f32x4 vn[4];
    if (gw < S) {
#pragma unroll
        for (int j = 0; j < 4; ++j) vn[j] = ((const f32x4*)(h + (size_t)gw * D) + lane)[64 * j]; }
    for (int m = gw; m < S; m += NGW) {
        f32x4 v[4]; float s = 0.f;
#pragma unroll
        for (int j = 0; j < 4; ++j) { v[j] = vn[j]; s += (v[j].x * v[j].x + v[j].y * v[j].y) + (v[j].z * v[j].z + v[j].w * v[j].w); }
        if (m + NGW < S) {
#pragma unroll
            for (int j = 0; j < 4; ++j) vn[j] = ((const f32x4*)(h + (size_t)(m + NGW) * D) + lane)[64 * j]; }
        const float r = rsqrtf(wave_sum(s) * (1.f / D) + RMS_EPS);
        u32x2* o8 = (u32x2*)(xn + (size_t)m * D) + lane;
#pragma unroll
        for (int j = 0; j < 4; ++j) { const f32x4 y = v[j] * r * g[j]; u32x2 w; w.x = pk2(y.x, y.y); w.y = pk2(y.z, y.w); o8[64 * j] = w; }
    }
}
__device__ __forceinline__ void final_norm_phase(float* h, const float* gain, int gw_unused, int NGW, int lane_unused) {
    const int ftid = fresh_tid(); const int lane = ftid & 63; const int gw = blockIdx.x * 8 + __builtin_amdgcn_readfirstlane(ftid >> 6);
    f32x4 g[4];
#pragma unroll
    for (int j = 0; j < 4; ++j) g[j] = ((const f32x4*)gain)[lane + 64 * j];
    f32x4 vn[4];
    if (gw < S) {
#pragma unroll
        for (int j = 0; j < 4; ++j) vn[j] = ((const f32x4*)(h + (size_t)gw * D) + lane)[64 * j]; }
    for (int m = gw; m < S; m += NGW) {
        f32x4* xr = (f32x4*)(h + (size_t)m * D) + lane; f32x4 v[4]; float s = 0.f;
#pragma unroll
        for (int j = 0; j < 4; ++j) { v[j] = vn[j]; s += (v[j].x * v[j].x + v[j].y * v[j].y) + (v[j].z * v[j].z + v[j].w * v[j].w); }
        if (m + NGW < S) {
#pragma unroll
            for (int j = 0; j < 4; ++j) vn[j] = ((const f32x4*)(h + (size_t)(m + NGW) * D) + lane)[64 * j]; }
        const float r = rsqrtf(wave_sum(s) * (1.f / D) + RMS_EPS);
#pragma unroll
        for (int j = 0; j < 4; ++j) xr[64 * j] = v[j] * r * g[j];
    }
}

__device__ __forceinline__ void unpack8(const u32x4 w, float* f) {
    f[0] = __builtin_bit_cast(float, w.x << 16); f[1] = __builtin_bit_cast(float, w.x & 0xffff0000u);
    f[2] = __builtin_bit_cast(float, w.y << 16); f[3] = __builtin_bit_cast(float, w.y & 0xffff0000u);
    f[4] = __builtin_bit_cast(float, w.z << 16); f[5] = __builtin_bit_cast(float, w.z & 0xffff0000u);
    f[6] = __builtin_bit_cast(float, w.w << 16); f[7] = __builtin_bit_cast(float, w.w & 0xffff0000u);
}

template <int W> __device__ __forceinline__ void pool_item(const bf16_t* xn, bf16_t* pd, int t, int ch, int g) {
    float a[8] = {0.f, 0.f, 0.f, 0.f, 0.f, 0.f, 0.f, 0.f}, x0[8];
    u32x4 v[W];
#pragma unroll
    for (int i = 0; i < W; ++i) { const int tt = t - i >= 0 ? t - i : 0; v[i] = *(const u32x4*)(xn + (size_t)tt * D + ch * 8); }
    unpack8(v[0], x0);
#pragma unroll
    for (int i = 0; i < W; ++i) { float x[8]; unpack8(v[i], x); const float k = (t - i >= 0) ? 1.f : 0.f;
#pragma unroll
        for (int e = 0; e < 8; ++e) a[e] += k * x[e]; }
    const int cnt = t + 1 < W ? t + 1 : W; const float inv = 1.f / (float)cnt;
#pragma unroll
    for (int e = 0; e < 8; ++e) a[e] = a[e] * inv - x0[e];
    u32x4 o; o.x = pk2(a[0], a[1]); o.y = pk2(a[2], a[3]); o.z = pk2(a[4], a[5]); o.w = pk2(a[6], a[7]);
    *(u32x4*)(pd + ((size_t)g * S + t) * 256 + (ch & 31) * 8) = o;
}
__device__ __forceinline__ void pool_diff_phase(const bf16_t* xn, bf16_t* pd, int gtid_unused, int NT) {
    const int gtid = blockIdx.x * 512 + fresh_tid();
#pragma unroll 2
    for (int it = gtid; it < S * 128; it += NT) {
        const int c32 = it & 31, t = ((it >> 8) << 1) + ((it >> 5) & 1), g = (it >> 6) & 3, ch = g * 32 + c32;
        if (g == 0) pool_item<2>(xn, pd, t, ch, g); else if (g == 1) pool_item<4>(xn, pd, t, ch, g); else if (g == 2) pool_item<8>(xn, pd, t, ch, g); else pool_item<16>(xn, pd, t, ch, g);
    }
}

__device__ __forceinline__ void conv_phase(const bf16_t* bcu, const float* cw, bf16_t* y, int gtid_unused, int NT) {
    const int gtid = blockIdx.x * 512 + fresh_tid();
#pragma unroll 2
    for (int it = gtid; it < S * 128; it += NT) {
        const int t = it >> 7, ch = it & 127; float acc[8] = {0.f, 0.f, 0.f, 0.f, 0.f, 0.f, 0.f, 0.f};
#pragma unroll
        for (int j = 0; j < 3; ++j) { const int tt = t - 2 + j;
            if (tt >= 0) { float c[8], uu[8]; unpack8(*(const u32x4*)(bcu + (size_t)tt * 3072 + 1024 + ch * 8), c); unpack8(*(const u32x4*)(bcu + (size_t)tt * 3072 + 2048 + ch * 8), uu);
                const f32x4 w0 = *(const f32x4*)(cw + j * D + ch * 8), w1 = *(const f32x4*)(cw + j * D + ch * 8 + 4);
#pragma unroll
                for (int e = 0; e < 4; ++e) { acc[e] += w0[e] * (c[e] * uu[e]); acc[4 + e] += w1[e] * (c[4 + e] * uu[4 + e]); } } }
        float b[8]; unpack8(*(const u32x4*)(bcu + (size_t)t * 3072 + ch * 8), b);
        u32x4 o; o.x = pk2(b[0] * acc[0], b[1] * acc[1]); o.y = pk2(b[2] * acc[2], b[3] * acc[3]); o.z = pk2(b[4] * acc[4], b[5] * acc[5]); o.w = pk2(b[6] * acc[6], b[7] * acc[7]);
        *(u32x4*)(y + (size_t)t * D + ch * 8) = o;
    }
}

__device__ __forceinline__ void qkt(f32x16& p0, f32x16& p1, ldsp Kslot, const bf16x8* qr, int r32, int hi) {
    ldsp kb = Kslot + hi * 1024 + r32 * 16;
    f32x16 z;
#pragma unroll
    for (int r = 0; r < 16; ++r) z[r] = 0.f;
    p0 = z; p1 = z;
    bf16x8 kf0[4], kf1[4];
#pragma unroll
    for (int d0 = 0; d0 < 4; ++d0) { kf0[d0] = *(const LAS bf16x8*)(kb + d0 * 2048); kf1[d0] = *(const LAS bf16x8*)(kb + d0 * 2048 + 512); }
    __builtin_amdgcn_s_setprio(1);
#pragma unroll
    for (int d0 = 0; d0 < 4; ++d0) {
        p0 = __builtin_amdgcn_mfma_f32_32x32x16_bf16(kf0[d0], qr[d0], p0, 0, 0, 0);
        p1 = __builtin_amdgcn_mfma_f32_32x32x16_bf16(kf1[d0], qr[d0], p1, 0, 0, 0);
    }
    __builtin_amdgcn_s_setprio(0);
}
__device__ __forceinline__ void qkt_acc(f32x16& p0, f32x16& p1, ldsp Kslot, const bf16x8* qr, int r32, int hi) {
    ldsp kb = Kslot + hi * 1024 + r32 * 16;
    bf16x8 kf0[4], kf1[4];
#pragma unroll
    for (int d0 = 0; d0 < 4; ++d0) { kf0[d0] = *(const LAS bf16x8*)(kb + d0 * 2048); kf1[d0] = *(const LAS bf16x8*)(kb + d0 * 2048 + 512); }
    __builtin_amdgcn_s_setprio(1);
#pragma unroll
    for (int d0 = 0; d0 < 4; ++d0) {
        p0 = __builtin_amdgcn_mfma_f32_32x32x16_bf16(kf0[d0], qr[d0], p0, 0, 0, 0);
        p1 = __builtin_amdgcn_mfma_f32_32x32x16_bf16(kf1[d0], qr[d0], p1, 0, 0, 0);
    }
    __builtin_amdgcn_s_setprio(0);
}
__device__ __forceinline__ s16x4 vtr(ldsp p) { return __builtin_bit_cast(s16x4, __builtin_amdgcn_ds_read_tr16_b64_v4i16((LAS s16x4*)p)); }
__device__ __forceinline__ void pv(f32x16* o, ldsp vp, const bf16x8 pa0, const bf16x8 pa1, const bf16x8 pa2, const bf16x8 pa3) {
    __builtin_amdgcn_s_setprio(1);
#pragma unroll
    for (int d0 = 0; d0 < 2; ++d0) {
#pragma unroll
        for (int ks = 0; ks < 4; ++ks) {
            const s16x4 lo = vtr(vp + d0 * 4096 + ks * 1024), hh = vtr(vp + d0 * 4096 + ks * 1024 + 512);
            const bf16x8 b = (bf16x8){lo[0], lo[1], lo[2], lo[3], hh[0], hh[1], hh[2], hh[3]};
            const bf16x8 a = ks == 0 ? pa0 : (ks == 1 ? pa1 : (ks == 2 ? pa2 : pa3));
            o[d0] = __builtin_amdgcn_mfma_f32_32x32x16_bf16(a, b, o[d0], 0, 0, 0);
        }
    }
    __builtin_amdgcn_s_setprio(0);
}
__device__ __forceinline__ float rowmax32(const f32x16& p0, const f32x16& p1) {
    float a = fmaxf(p0[0], p1[0]);
#pragma unroll
    for (int r = 1; r < 16; ++r) a = fmaxf(a, fmaxf(p0[r], p1[r]));
    return fmaxf(a, __shfl_xor(a, 32));
}
__device__ __forceinline__ void pack_p(const f32x16& p0, const f32x16& p1, bf16x8& a0, bf16x8& a1, bf16x8& a2, bf16x8& a3) {
    u32x4 w0, w1, w2, w3;
    w0 = (u32x4){pk2(p0[0], p0[1]), pk2(p0[2], p0[3]), pk2(p0[4], p0[5]), pk2(p0[6], p0[7])};
    w1 = (u32x4){pk2(p0[8], p0[9]), pk2(p0[10], p0[11]), pk2(p0[12], p0[13]), pk2(p0[14], p0[15])};
    w2 = (u32x4){pk2(p1[0], p1[1]), pk2(p1[2], p1[3]), pk2(p1[4], p1[5]), pk2(p1[6], p1[7])};
    w3 = (u32x4){pk2(p1[8], p1[9]), pk2(p1[10], p1[11]), pk2(p1[12], p1[13]), pk2(p1[14], p1[15])};
    a0 = __builtin_bit_cast(bf16x8, w0); a1 = __builtin_bit_cast(bf16x8, w1); a2 = __builtin_bit_cast(bf16x8, w2); a3 = __builtin_bit_cast(bf16x8, w3);
}
__device__ __forceinline__ void softmax_pv(f32x16& p0, f32x16& p1, float& m, float& l, f32x16* o, LAS float* wsf, ldsp vp, int r32, int hi) {
    const float rm = rowmax32(p0, p1);
    const float mn = fmaxf(m, rm), alpha = ex2(m - mn); m = mn;
    p0 = p0 - mn; p1 = p1 - mn;
#pragma unroll
    for (int r = 0; r < 16; ++r) { p0[r] = ex2(p0[r]); p1[r] = ex2(p1[r]); }
    float rs;
    { const f32x16 t = p0 + p1; typedef float f32x8 __attribute__((ext_vector_type(8)));
      const f32x8 t8 = __builtin_shufflevector(t, t, 0, 1, 2, 3, 4, 5, 6, 7) + __builtin_shufflevector(t, t, 8, 9, 10, 11, 12, 13, 14, 15);
      const f32x4 t4 = __builtin_shufflevector(t8, t8, 0, 1, 2, 3) + __builtin_shufflevector(t8, t8, 4, 5, 6, 7);
      rs = (t4[0] + t4[1]) + (t4[2] + t4[3]); }
    l = l * alpha + rs;
    if (!__all(alpha == 1.f)) {
        if (hi == 0) wsf[r32] = alpha;
#pragma unroll
        for (int r = 0; r < 16; ++r) { const float a = wsf[crow(r, hi)]; o[0][r] *= a; o[1][r] *= a; }
    }
    bf16x8 a0, a1, a2, a3; pack_p(p0, p1, a0, a1, a2, a3);
    pv(o, vp, a0, a1, a2, a3);
}
__device__ __forceinline__ u32x4 ld_k(const bf16_t* Kh, int pitch, int key0, int wid, int lane) { return *(const u32x4*)(Kh + (size_t)(key0 + lane) * pitch + wid * 8); }
__device__ __forceinline__ u32x4 ld_v(const bf16_t* Vh, int pitch, int key0, int wid, int lane) { return *(const u32x4*)(Vh + (size_t)(key0 + 16 * (wid & 3) + (lane >> 2)) * pitch + (wid >> 2) * 32 + (lane & 3) * 8); }
__device__ __forceinline__ void st_kv(ldsp slot, int wid, int lane, u32x4 v) { *(LAS u32x4*)(slot + wid * 1024 + lane * 16) = v; }

__device__ __forceinline__ void stage_o(const f32x16* o, const float* rs  , LAS bf16_t* stg, int r32, int hi) {
#pragma unroll
    for (int r = 0; r < 16; ++r) { const int orow = crow(r, hi);
#pragma unroll
        for (int d0 = 0; d0 < 2; ++d0) stg[orow * 64 + d0 * 32 + r32] = (bf16_t)f2bf(o[d0][r] * rs[r]); }
}

__device__ __forceinline__ void fox_unit(ldsp lds, int h, int qb, const bf16_t* Q, const bf16_t* Kb, const bf16_t* Vb, bf16_t* O, const float* lf, const unsigned* kmax, int tid, int lane, int wid) {
    asm volatile("" : "+v"(tid)); lane = tid & 63;
    const int r32 = lane & 31, hi = lane >> 5;
    LAS float* bias = (LAS float*)(lds + ATT_BIG);
    LAS float* part = (LAS float*)(lds + ATT_MISC);
    LAS float* wsf = (LAS float*)(lds + ATT_WSF) + wid * 64;
    const int q0 = qb * 256, nkeys = q0 + 256, NT = nkeys / 64;
    __syncthreads();
    const bf16_t* Kh = Kb + h * HD; const bf16_t* Vh = Vb + h * HD;
    const int tq = q0 + wid * 32 + r32;
    bf16x8 qr[4];
#pragma unroll
    for (int d0 = 0; d0 < 4; ++d0) qr[d0] = *(const bf16x8*)(Q + (size_t)tq * D + h * HD + d0 * 16 + hi * 8);
    u32x4 kreg = ld_k(Kh, D, (NT - 1) * 64, wid, lane), vreg = ld_v(Vh, D, (NT - 1) * 64, wid, lane);
    {
        const int pos0 = tid * 32; const bool act = pos0 < nkeys;
        f32x4 v[8]; float sum = 0.f;
#pragma unroll
        for (int i = 0; i < 8; ++i) { v[i] = act ? *(const f32x4*)(lf + (size_t)h * S + pos0 + 4 * i) : (f32x4){0.f, 0.f, 0.f, 0.f}; sum += (v[i].x + v[i].y) + (v[i].z + v[i].w); }
        float incl = sum;
#pragma unroll
        for (int off = 1; off < 64; off <<= 1) { const float t = __shfl_up(incl, off); if (lane >= off) incl += t; }
        if (lane == 63) part[wid] = incl;
        __syncthreads();
        float run = incl - sum, tot = 0.f;
        for (int w = 0; w < 8; ++w) { const float pw = part[w]; tot += pw; if (w < wid) run += pw; }
        if (act) {
#pragma unroll
            for (int i = 0; i < 8; ++i) { f32x4 c; run += v[i].x; c.x = (tot - run) * LOG2E; run += v[i].y; c.y = (tot - run) * LOG2E; run += v[i].z; c.z = (tot - run) * LOG2E; run += v[i].w; c.w = (tot - run) * LOG2E;
                *(LAS f32x4*)(bias + pos0 + 4 * i) = c; }
        }
    }
    float U;
    { float q2 = 0.f;
#pragma unroll
      for (int d0 = 0; d0 < 4; ++d0)
#pragma unroll
          for (int e = 0; e < 8; ++e) { const float f = bf2f((unsigned short)qr[d0][e]); q2 += f * f; }
      q2 += __shfl_xor(q2, 32);
      const float k2 = __builtin_bit_cast(float, kmax[h * 2]) + __builtin_bit_cast(float, kmax[h * 2 + 1]);
      U = sqrtf(q2 * k2) * 1.001f + 40.f; }
    float m = NEGF, l = 0.f; f32x16 o[2];
#pragma unroll
    for (int r = 0; r < 16; ++r) { o[0][r] = 0.f; o[1][r] = 0.f; }
    const int vlane = ((lane >> 4) & 1) * 32 + (lane & 3) * 8 + (4 * hi + ((lane & 15) >> 2)) * 64;
    st_kv(lds + ATT_BUF, wid, lane, kreg); st_kv(lds + ATT_BUF + 8192, wid, lane, vreg);
    if (NT > 1) { kreg = ld_k(Kh, D, (NT - 2) * 64, wid, lane); vreg = ld_v(Vh, D, (NT - 2) * 64, wid, lane); }
    __syncthreads();
    const int wq_lo = q0 + wid * 32;
    int done = 0;
    for (int t = NT - 1, it = 0; t >= 0; --t, ++it) {
        ldsp Ks = lds + ATT_BUF + (it & 1) * 16384; ldsp Vs = Ks + 8192;
        u32x4 kfar = kreg, vfar = vreg;
        if (t > 1) { kfar = ld_k(Kh, D, (t - 2) * 64, wid, lane); vfar = ld_v(Vh, D, (t - 2) * 64, wid, lane); }
        if (!done && 64 * t <= wq_lo + 31) {
            done = __all(U + bias[64 * t + 63] < m);
            if (!done) {
                f32x16 p0, p1;
#pragma unroll
                for (int a = 0; a < 4; ++a) { const f32x4 b0 = *(const LAS f32x4*)(bias + 64 * t + 8 * a + 4 * hi), b1 = *(const LAS f32x4*)(bias + 64 * t + 32 + 8 * a + 4 * hi);
#pragma unroll
                    for (int b = 0; b < 4; ++b) { p0[4 * a + b] = b0[b]; p1[4 * a + b] = b1[b]; } }
                qkt_acc(p0, p1, Ks, qr, r32, hi);
                if (64 * t + 63 > wq_lo) {
#pragma unroll
                    for (int r = 0; r < 16; ++r) { const int kv = 64 * t + crow(r, hi); if (kv > tq) p0[r] = NEGF; if (kv + 32 > tq) p1[r] = NEGF; }
                }
                softmax_pv(p0, p1, m, l, o, wsf, Vs + vlane, r32, hi);
            }
        }
        if (t > 0) { ldsp Kn = lds + ATT_BUF + ((it + 1) & 1) * 16384; st_kv(Kn, wid, lane, kreg); st_kv(Kn + 8192, wid, lane, vreg); }
        kreg = kfar; vreg = vfar;
        if (__syncthreads_and(done)) break;
    }
    l += __shfl_xor(l, 32);
    if (hi == 0) wsf[32 + r32] = l;
    float rs[16];
#pragma unroll
    for (int r = 0; r < 16; ++r) rs[r] = 1.f / wsf[32 + crow(r, hi)];
    LAS bf16_t* stg = (LAS bf16_t*)(lds + ATT_OST) + wid * 2048;
    stage_o(o, rs, stg, r32, hi);
    bf16_t* Ow = O + (size_t)(q0 + wid * 32) * D + h * HD;
#pragma unroll
    for (int i = 0; i < 4; ++i) { const int row = i * 8 + (lane >> 3), ch = lane & 7; const u32x4 v = *(const LAS u32x4*)(stg + row * 64 + ch * 8); *(u32x4*)(Ow + (size_t)row * D + ch * 8) = v; }
}

__device__ __forceinline__ void nsa_win_unit(ldsp lds, int kvh, int qblk, const bf16_t* Qn, const bf16_t* Kw, const bf16_t* Vw, const float* gates, bf16_t* O3, int tid, int lane, int wid) {
    asm volatile("" : "+v"(tid)); lane = tid & 63;
    const int r32 = lane & 31, hi = lane >> 5;
    LAS float* wsf = (LAS float*)(lds + ATT_WSF) + wid * 64;
    const int q0 = qblk * 64;
    const int tq = q0 + 8 * wid + (r32 >> 2), head = 4 * kvh + (r32 & 3);
    __syncthreads();
    bf16x8 qr[4];
#pragma unroll
    for (int d0 = 0; d0 < 4; ++d0) qr[d0] = *(const bf16x8*)(Qn + (size_t)tq * D + head * HD + d0 * 16 + hi * 8);
    float m = NEGF, l = 0.f; f32x16 o[2];
#pragma unroll
    for (int r = 0; r < 16; ++r) { o[0][r] = 0.f; o[1][r] = 0.f; }
    const int vlane = ((lane >> 4) & 1) * 32 + (lane & 3) * 8 + (4 * hi + ((lane & 15) >> 2)) * 64;
    const bf16_t* Kh = Kw + (size_t)kvh * S * 64; const bf16_t* Vh = Vw + (size_t)kvh * S * 64;
    const int t_hi = qblk, t_lo = qblk - 8 > 0 ? qblk - 8 : 0;
    u32x4 kreg = ld_k(Kh, 64, t_lo * 64, wid, lane), vreg = ld_v(Vh, 64, t_lo * 64, wid, lane);
    st_kv(lds + ATT_BUF, wid, lane, kreg); st_kv(lds + ATT_BUF + 8192, wid, lane, vreg);
    if (t_lo < t_hi) { kreg = ld_k(Kh, 64, (t_lo + 1) * 64, wid, lane); vreg = ld_v(Vh, 64, (t_lo + 1) * 64, wid, lane); }
    __syncthreads();
    for (int t = t_lo; t <= t_hi; ++t) {
        const int b = (t - t_lo) & 1;
        ldsp Ks = lds + ATT_BUF + b * 16384; ldsp Vs = Ks + 8192;
        u32x4 kfar = kreg, vfar = vreg;
        if (t + 2 <= t_hi) { kfar = ld_k(Kh, 64, (t + 2) * 64, wid, lane); vfar = ld_v(Vh, 64, (t + 2) * 64, wid, lane); }
        {
            f32x16 p0, p1; qkt(p0, p1, Ks, qr, r32, hi);
#pragma unroll
            for (int r = 0; r < 16; ++r) { const int kv = 64 * t + crow(r, hi);
                if (kv > tq || kv + 512 <= tq) p0[r] = NEGF;
                if (kv + 32 > tq || kv + 32 + 512 <= tq) p1[r] = NEGF; }
            softmax_pv(p0, p1, m, l, o, wsf, Vs + vlane, r32, hi);
        }
        if (t < t_hi) { ldsp Kn = lds + ATT_BUF + (b ^ 1) * 16384; st_kv(Kn, wid, lane, kreg); st_kv(Kn + 8192, wid, lane, vreg); }
        kreg = kfar; vreg = vfar;
        __syncthreads();
    }
    l += __shfl_xor(l, 32);
    if (hi == 0) wsf[32 + r32] = l;
    float rs[16];
#pragma unroll
    for (int r = 0; r < 16; ++r) { const int col = crow(r, hi); const float gt = gates[(size_t)(q0 + 8 * wid + (col >> 2)) * 48 + 32 + 4 * kvh + (col & 3)]; rs[r] = gt / wsf[32 + col]; }
    LAS bf16_t* stg = (LAS bf16_t*)(lds + ATT_OST) + wid * 2048;
    stage_o(o, rs, stg, r32, hi);
#pragma unroll
    for (int i = 0; i < 4; ++i) { const int row = i * 8 + (lane >> 3), ch = lane & 7; const u32x4 v = *(const LAS u32x4*)(stg + row * 64 + ch * 8);
        *(u32x4*)(O3 + (size_t)(q0 + 8 * wid + (row >> 2)) * 3072 + 2048 + (4 * kvh + (row & 3)) * HD + ch * 8) = v; }
}

__device__ __forceinline__ long lo64(const u32x4 v) { return (long)(((unsigned long long)v.y << 32) | v.x); }
__device__ __forceinline__ long hi64(const u32x4 v) { return (long)(((unsigned long long)v.w << 32) | v.z); }
__device__ __forceinline__ void sel_load4(u32x4* f, const unsigned char* B, int j) {
    const unsigned char* p = B + (size_t)j * 4096;
#pragma unroll
    for (int g4 = 0; g4 < 4; ++g4) f[g4] = *(const u32x4*)(p + g4 * 1024);
}
__device__ __forceinline__ void sel_fetch4(u32x4* f, const unsigned char* B, ldsp lc, int j, int cur) {
    const int jj = j < 0 ? 0 : j;
    const int fs = jj == 0 ? 0 : (jj == cur ? 2 : (jj == cur - 1 ? 1 : -1));
    if (fs >= 0) {
#pragma unroll
        for (int g4 = 0; g4 < 4; ++g4) f[g4] = *(const LAS u32x4*)(lc + fs * 8192 + g4 * 1024);
    } else sel_load4(f, B, jj);
}
__device__ __forceinline__ void sel_compute(const u32x4* fK, const u32x4* fV, const long* Qb, bool diag, int lim, int kg, float& ms, float& ls, f32x4* oa) {
    f32x4 sc[4];
    __builtin_amdgcn_s_setprio(1);
#pragma unroll
    for (int g4 = 0; g4 < 4; ++g4) { sc[g4] = __builtin_amdgcn_mfma_f32_16x16x32_fp8_fp8(lo64(fK[g4]), Qb[0], (f32x4){0.f, 0.f, 0.f, 0.f}, 0, 0, 0); sc[g4] = __builtin_amdgcn_mfma_f32_16x16x32_fp8_fp8(hi64(fK[g4]), Qb[1], sc[g4], 0, 0, 0); }
    __builtin_amdgcn_s_setprio(0);
    if (diag) {
#pragma unroll
        for (int g4 = 0; g4 < 4; ++g4)
#pragma unroll
            for (int r = 0; r < 4; ++r) if (16 * g4 + 4 * kg + r > lim) sc[g4][r] = NEGF; }
    float lm = fmaxf(fmaxf(sc[0][0], sc[0][1]), fmaxf(sc[0][2], sc[0][3]));
#pragma unroll
    for (int g4 = 1; g4 < 4; ++g4) lm = fmaxf(lm, fmaxf(fmaxf(sc[g4][0], sc[g4][1]), fmaxf(sc[g4][2], sc[g4][3])));
    lm *= C2;
    if (__any(lm > ms + 8.f)) {
        float rm = fmaxf(lm, __shfl_xor(lm, 16)); rm = fmaxf(rm, __shfl_xor(rm, 32));
        const float mn = fmaxf(ms, rm), alpha = ex2(ms - mn); ms = mn; ls *= alpha;
#pragma unroll
        for (int dg = 0; dg < 4; ++dg) oa[dg] = oa[dg] * alpha;
    }
#pragma unroll
    for (int g4 = 0; g4 < 4; ++g4) { sc[g4] = sc[g4] * C2 - ms;
#pragma unroll
        for (int r = 0; r < 4; ++r) sc[g4][r] = ex2(sc[g4][r]); }
    { const f32x4 t4 = (sc[0] + sc[1]) + (sc[2] + sc[3]); ls += (t4[0] + t4[1]) + (t4[2] + t4[3]); }
    long Pb[2];
#pragma unroll
    for (int s2 = 0; s2 < 2; ++s2) Pb[s2] = pk8_fp8(sc[2 * s2][0], sc[2 * s2][1], sc[2 * s2][2], sc[2 * s2][3], sc[2 * s2 + 1][0], sc[2 * s2 + 1][1], sc[2 * s2 + 1][2], sc[2 * s2 + 1][3]);
    __builtin_amdgcn_s_setprio(1);
#pragma unroll
    for (int dg = 0; dg < 4; ++dg) { oa[dg] = __builtin_amdgcn_mfma_f32_16x16x32_fp8_fp8(lo64(fV[dg]), Pb[0], oa[dg], 0, 0, 0); oa[dg] = __builtin_amdgcn_mfma_f32_16x16x32_fp8_fp8(hi64(fV[dg]), Pb[1], oa[dg], 0, 0, 0); }
    __builtin_amdgcn_s_setprio(0);
}

__device__ __forceinline__ float quad_sum(float v) { v += __shfl_xor(v, 1); v += __shfl_xor(v, 2); return v; }

__device__ __forceinline__ void nsa_cs_unit(ldsp lds, int kvh, int qblk, const bf16_t* Qn, const bf16_t* Kc, const bf16_t* Vc, const bf16_t* Ksl, const bf16_t* Vst, const bf16_t* Kw, const bf16_t* Vw, const float* gates, bf16_t* O3, int tid, int lane, int wid) {
    asm volatile("" : "+v"(tid)); lane = tid & 63;
    const int r32 = lane & 31, hi = lane >> 5;
    LAS float* wsf = (LAS float*)(lds + ATT_WSF) + wid * 64;
    LAS float* imp = (LAS float*)(lds + ATT_BIG);
    LAS int* sel = (LAS int*)(lds + ATT_SEL);
    const int q0 = qblk * 64;
    const int qloc = 8 * wid + (r32 >> 2);
    const int tq = q0 + qloc, head = 4 * kvh + (r32 & 3);
    __syncthreads();
    for (int i = tid; i < 64 * 256 / 4; i += 512) ((LAS f32x4*)imp)[i] = (f32x4){0.f, 0.f, 0.f, 0.f};
    bf16x8 qr[4];
#pragma unroll
    for (int d0 = 0; d0 < 4; ++d0) qr[d0] = *(const bf16x8*)(Qn + (size_t)tq * D + head * HD + d0 * 16 + hi * 8);
    const int vlane = ((lane >> 4) & 1) * 32 + (lane & 3) * 8 + (4 * hi + ((lane & 15) >> 2)) * 64;
    const bf16_t* Kh = Kc + (size_t)kvh * 1024 * 64; const bf16_t* Vh = Vc + (size_t)kvh * 1024 * 64;
    int ncmp = q0 / 16 + 3; if (ncmp > NCMP) ncmp = NCMP;
    const int NTc = (ncmp + 63) / 64;
    float m = NEGF, l = 0.f;
    {
        u32x4 kreg = ld_k(Kh, 64, 0, wid, lane);
        st_kv(lds + ATT_BUF, wid, lane, kreg);
        if (NTc > 1) kreg = ld_k(Kh, 64, 64, wid, lane);
        __syncthreads();
        for (int t = 0; t < NTc; ++t) {
            ldsp Ks = lds + ATT_BUF + (t & 1) * 16384;
            u32x4 kfar = kreg;
            if (t + 2 < NTc) kfar = ld_k(Kh, 64, (t + 2) * 64, wid, lane);
            f32x16 p0, p1; qkt(p0, p1, Ks, qr, r32, hi);
            if (1024 * t + 1039 > q0) {
#pragma unroll
                for (int r = 0; r < 16; ++r) { const int n = 64 * t + crow(r, hi); if (16 * n + 31 > tq) p0[r] = NEGF; if (16 * (n + 32) + 31 > tq) p1[r] = NEGF; } }
            const float rm = rowmax32(p0, p1); const float mn = fmaxf(m, rm), alpha = ex2(m - mn); m = mn; float rs;
            p0 = p0 - mn; p1 = p1 - mn;
#pragma unroll
            for (int r = 0; r < 16; ++r) { p0[r] = ex2(p0[r]); p1[r] = ex2(p1[r]); }
            { const f32x16 t = p0 + p1; typedef float f32x8 __attribute__((ext_vector_type(8)));
              const f32x8 t8 = __builtin_shufflevector(t, t, 0, 1, 2, 3, 4, 5, 6, 7) + __builtin_shufflevector(t, t, 8, 9, 10, 11, 12, 13, 14, 15);
              const f32x4 t4 = __builtin_shufflevector(t8, t8, 0, 1, 2, 3) + __builtin_shufflevector(t8, t8, 4, 5, 6, 7);
              rs = (t4[0] + t4[1]) + (t4[2] + t4[3]); }
            l = l * alpha + rs;
            if (t + 1 < NTc) st_kv(lds + ATT_BUF + ((t + 1) & 1) * 16384, wid, lane, kreg);
            kreg = kfar;
            __syncthreads();
        }
        l += __shfl_xor(l, 32);
    }
    const bool rowvalid = m > -1e29f;
    const float mfin = rowvalid ? m + log2f(l) : 1e30f;
    f32x16 o[2];
#pragma unroll
    for (int r = 0; r < 16; ++r) { o[0][r] = 0.f; o[1][r] = 0.f; }
    {
        float carry = 0.f;
        u32x4 kreg = ld_k(Kh, 64, 0, wid, lane), vreg = ld_v(Vh, 64, 0, wid, lane);
        st_kv(lds + ATT_BUF, wid, lane, kreg); st_kv(lds + ATT_BUF + 8192, wid, lane, vreg);
        if (NTc > 1) { kreg = ld_k(Kh, 64, 64, wid, lane); vreg = ld_v(Vh, 64, 64, wid, lane); }
        __syncthreads();
        for (int t = 0; t < NTc; ++t) {
            ldsp Ks = lds + ATT_BUF + (t & 1) * 16384; ldsp Vs = Ks + 8192;
            u32x4 kfar = kreg, vfar = vreg;
            if (t + 2 < NTc) { kfar = ld_k(Kh, 64, (t + 2) * 64, wid, lane); vfar = ld_v(Vh, 64, (t + 2) * 64, wid, lane); }
            f32x16 p0, p1; qkt(p0, p1, Ks, qr, r32, hi);
            if (1024 * t + 1039 > q0) {
#pragma unroll
                for (int r = 0; r < 16; ++r) { const int n = 64 * t + crow(r, hi);
                    p0[r] = (16 * n + 31 > tq) ? 0.f : ex2(p0[r] - mfin);
                    p1[r] = (16 * (n + 32) + 31 > tq) ? 0.f : ex2(p1[r] - mfin); }
            } else {
                p0 = p0 - mfin; p1 = p1 - mfin;
#pragma unroll
                for (int r = 0; r < 16; ++r) { p0[r] = ex2(p0[r]); p1[r] = ex2(p1[r]); }
            }
            float G0[4], G1[4], e0[4], e1[4];
#pragma unroll
            for (int a = 0; a < 4; ++a) { G0[a] = quad_sum((p0[4 * a] + p0[4 * a + 1]) + (p0[4 * a + 2] + p0[4 * a + 3])); G1[a] = quad_sum((p1[4 * a] + p1[4 * a + 1]) + (p1[4 * a + 2] + p1[4 * a + 3]));
                e0[a] = quad_sum(p0[4 * a + 3]); e1[a] = quad_sum(p1[4 * a + 3]); }
            float x0[4], x1[4];
#pragma unroll
            for (int a = 0; a < 4; ++a) { x0[a] = __shfl_xor(e0[a], 32); x1[a] = __shfl_xor(e1[a], 32); }
            float ex0[4], ex1[4];
            if (hi == 1) {
#pragma unroll
                for (int a = 0; a < 4; ++a) { ex0[a] = x0[a]; ex1[a] = x1[a]; }
            } else {
                ex0[0] = carry; ex0[1] = x0[0]; ex0[2] = x0[1]; ex0[3] = x0[2];
                ex1[0] = x0[3]; ex1[1] = x1[0]; ex1[2] = x1[1]; ex1[3] = x1[2];
                carry = x1[3];
            }
            if ((r32 & 3) == 0) {
#pragma unroll
                for (int a = 0; a < 4; ++a) { imp[qloc * 256 + 16 * t + 2 * a + hi] = G0[a] + ex0[a]; imp[qloc * 256 + 16 * t + 8 + 2 * a + hi] = G1[a] + ex1[a]; }
            }
            bf16x8 a0, a1, a2, a3; pack_p(p0, p1, a0, a1, a2, a3);
            pv(o, Vs + vlane, a0, a1, a2, a3);
            if (t + 1 < NTc) { ldsp Kn = lds + ATT_BUF + ((t + 1) & 1) * 16384; st_kv(Kn, wid, lane, kreg); st_kv(Kn + 8192, wid, lane, vreg); }
            kreg = kfar; vreg = vfar;
            __syncthreads();
        }
    }
    LAS bf16_t* stg = (LAS bf16_t*)(lds + ATT_OST) + wid * 2048;
    {
        float rs[16];
#pragma unroll
        for (int r = 0; r < 16; ++r) { const int col = crow(r, hi); rs[r] = gates[(size_t)(q0 + 8 * wid + (col >> 2)) * 48 + 4 * kvh + (col & 3)]; }
        stage_o(o, rs, stg, r32, hi);
    }
    for (int qi = 0; qi < 8; ++qi) {
        const int ql = 8 * wid + qi, t = q0 + ql, cur = t >> 6;
        unsigned long long key[4];
#pragma unroll
        for (int i = 0; i < 4; ++i) { const int j = lane + 64 * i; float v = imp[ql * 256 + j];
            if (j == 0 || j == cur || j == cur - 1) v = 1e9f;
            if (j > cur) v = NEGF;
            unsigned ub = __builtin_bit_cast(unsigned, v); ub = (ub & 0x80000000u) ? ~ub : (ub | 0x80000000u);
            key[i] = ((unsigned long long)ub << 8) | (unsigned)(255 - j); }
        unsigned long long T = 0ull;
        for (int b = 39; b >= 0; --b) { const unsigned long long Tt = T | (1ull << b); int cnt = 0;
#pragma unroll
            for (int i = 0; i < 4; ++i) cnt += __popcll(__ballot(key[i] >= Tt));
            if (cnt >= 16) T = Tt;
            if (cnt == 16) break; }
        int base = 0;
#pragma unroll
        for (int i = 0; i < 4; ++i) { const int j = lane + 64 * i; const bool in = key[i] >= T; const unsigned long long mk = __ballot(in);
            const int pos = base + __popcll(mk & ((1ull << lane) - 1ull));
            if (in && pos < 16) sel[ql * 16 + pos] = (j <= cur) ? j : -1;
            base += __popcll(mk); }
    }
    { const unsigned char* gsrc = (tid < 256 ? (const unsigned char*)Ksl + (size_t)kvh * S * 64 : (const unsigned char*)Vst + (size_t)kvh * 256 * 4096) + (size_t)(tid & 255) * 16;
#pragma unroll
      for (int sl = 0; sl < 3; ++sl) { const int jb_ = sl == 0 ? 0 : (sl == 1 ? (qblk > 0 ? qblk - 1 : 0) : qblk);
          *(LAS u32x4*)(lds + ATT_BUF + sl * 8192 + (tid < 256 ? 0 : 4096) + (tid & 255) * 16) = *(const u32x4*)(gsrc + (size_t)jb_ * 4096); }
    }
    __syncthreads();
    {
        const int n = lane & 15, kg = lane >> 4;
        const unsigned char* Kb = (const unsigned char*)Ksl + (size_t)kvh * S * 64 + (size_t)n * 64 + 16 * kg; const unsigned char* Vb = (const unsigned char*)Vst + (size_t)kvh * 256 * 4096 + (size_t)n * 64 + 16 * kg;
        ldsp lck = lds + ATT_BUF + n * 64 + 16 * kg; ldsp lcv = lck + 4096;
        const int cur = qblk;
        u32x4 Ks[2][4], Vs2[2][4];
        const u32x4 zq = {0u, 0u, 0u, 0u};
        const bf16_t* qp0 = Qn + (size_t)(q0 + 8 * wid) * D + (4 * kvh + (n & 3)) * HD + 16 * kg;
        u32x4 qan = n < 4 ? *(const u32x4*)qp0 : zq, qbn = n < 4 ? *(const u32x4*)(qp0 + 8) : zq;
        int jn0 = __builtin_amdgcn_readfirstlane(sel[(8 * wid) * 16]);
        sel_fetch4(Ks[0], Kb, lck, jn0, cur); sel_fetch4(Vs2[0], Vb, lcv, jn0, cur);
        for (int qi = 0; qi < 8; ++qi) {
            const int ql = 8 * wid + qi, t = q0 + ql, lim = t & 63;
            long Qb[2];
            { float fa8[8], fb8[8]; unpack8(qan, fa8); unpack8(qbn, fb8);
              const float ic = 1.f / C2;
              Qb[0] = pk8_fp8(fa8[0] * ic, fa8[1] * ic, fa8[2] * ic, fa8[3] * ic, fa8[4] * ic, fa8[5] * ic, fa8[6] * ic, fa8[7] * ic);
              Qb[1] = pk8_fp8(fb8[0] * ic, fb8[1] * ic, fb8[2] * ic, fb8[3] * ic, fb8[4] * ic, fb8[5] * ic, fb8[6] * ic, fb8[7] * ic); }
            if (qi + 1 < 8) { const bf16_t* qp = qp0 + (size_t)(qi + 1) * D; qan = n < 4 ? *(const u32x4*)qp : zq; qbn = n < 4 ? *(const u32x4*)(qp + 8) : zq; }
            float ms = NEGF, ls = 0.f; f32x4 oa[4];
#pragma unroll
            for (int dg = 0; dg < 4; ++dg) oa[dg] = (f32x4){0.f, 0.f, 0.f, 0.f};
#pragma unroll
            for (int it = 0; it < 16; ++it) {
                int jn1 = -1;
                if (it + 1 < 16) { jn1 = __builtin_amdgcn_readfirstlane(sel[ql * 16 + it + 1]); sel_fetch4(Ks[(it + 1) & 1], Kb, lck, jn1, cur); sel_fetch4(Vs2[(it + 1) & 1], Vb, lcv, jn1, cur); }
                else if (qi + 1 < 8) { jn1 = __builtin_amdgcn_readfirstlane(sel[(ql + 1) * 16]); sel_fetch4(Ks[0], Kb, lck, jn1, cur); sel_fetch4(Vs2[0], Vb, lcv, jn1, cur); }
                const int lim_i = jn0 < 0 ? -1 : (jn0 == cur ? lim : 63);
                sel_compute(Ks[it & 1], Vs2[it & 1], Qb, lim_i < 63, lim_i, kg, ms, ls, oa);
                jn0 = jn1;
                __builtin_amdgcn_sched_barrier(0);
            }
            ls += __shfl_xor(ls, 16); ls += __shfl_xor(ls, 32);
            if (n < 4) { const float gs = gates[(size_t)t * 48 + 16 + 4 * kvh + n] / ls;
#pragma unroll
                for (int dg = 0; dg < 4; ++dg) { const f32x4 v = oa[dg] * gs; LAS u32x2* sp = (LAS u32x2*)(stg + (qi * 4 + n) * 64 + 16 * dg + 4 * kg); const u32x2 ov = *sp;
                    u32x2 w; w.x = pk2(v[0] + __builtin_bit_cast(float, ov.x << 16), v[1] + __builtin_bit_cast(float, ov.x & 0xffff0000u)); w.y = pk2(v[2] + __builtin_bit_cast(float, ov.y << 16), v[3] + __builtin_bit_cast(float, ov.y & 0xffff0000u));
                    *sp = w; } }
        }
    }
    {
        float m2 = NEGF, l2 = 0.f;
#pragma unroll
        for (int r = 0; r < 16; ++r) { o[0][r] = 0.f; o[1][r] = 0.f; }
        const bf16_t* Kwh = Kw + (size_t)kvh * S * 64; const bf16_t* Vwh = Vw + (size_t)kvh * S * 64;
        const int t_hi = qblk, t_lo = qblk - 8 > 0 ? qblk - 8 : 0;
        __syncthreads();
        u32x4 kreg = ld_k(Kwh, 64, t_lo * 64, wid, lane), vreg = ld_v(Vwh, 64, t_lo * 64, wid, lane);
        st_kv(lds + ATT_BUF, wid, lane, kreg); st_kv(lds + ATT_BUF + 8192, wid, lane, vreg);
        if (t_lo < t_hi) { kreg = ld_k(Kwh, 64, (t_lo + 1) * 64, wid, lane); vreg = ld_v(Vwh, 64, (t_lo + 1) * 64, wid, lane); }
        __syncthreads();
        for (int t = t_lo; t <= t_hi; ++t) {
            const int b = (t - t_lo) & 1;
            ldsp Ks = lds + ATT_BUF + b * 16384; ldsp Vs = Ks + 8192;
            u32x4 kfar = kreg, vfar = vreg;
            if (t + 2 <= t_hi) { kfar = ld_k(Kwh, 64, (t + 2) * 64, wid, lane); vfar = ld_v(Vwh, 64, (t + 2) * 64, wid, lane); }
            {
                f32x16 p0, p1; qkt(p0, p1, Ks, qr, r32, hi);
                if (t == t_hi || t == qblk - 8) {
#pragma unroll
                    for (int r = 0; r < 16; ++r) { const int kv = 64 * t + crow(r, hi);
                        if (kv > tq || kv + 512 <= tq) p0[r] = NEGF;
                        if (kv + 32 > tq || kv + 32 + 512 <= tq) p1[r] = NEGF; } }
                softmax_pv(p0, p1, m2, l2, o, wsf, Vs + vlane, r32, hi);
            }
            if (t < t_hi) { ldsp Kn = lds + ATT_BUF + (b ^ 1) * 16384; st_kv(Kn, wid, lane, kreg); st_kv(Kn + 8192, wid, lane, vreg); }
            kreg = kfar; vreg = vfar;
            __syncthreads();
        }
        l2 += __shfl_xor(l2, 32);
        if (hi == 0) wsf[32 + r32] = l2;
#pragma unroll
        for (int r = 0; r < 16; ++r) { const int col = crow(r, hi); const float gt = gates[(size_t)(q0 + 8 * wid + (col >> 2)) * 48 + 32 + 4 * kvh + (col & 3)]; const float rsw = gt / wsf[32 + col];
#pragma unroll
            for (int d0 = 0; d0 < 2; ++d0) { LAS bf16_t* sp = stg + col * 64 + d0 * 32 + r32; *sp = (bf16_t)f2bf(bf2f(*sp) + o[d0][r] * rsw); } }
#pragma unroll
        for (int i = 0; i < 4; ++i) { const int row = i * 8 + (lane >> 3), ch = lane & 7; const u32x4 v = *(const LAS u32x4*)(stg + row * 64 + ch * 8);
            *(u32x4*)(O3 + (size_t)(q0 + 8 * wid + (row >> 2)) * D + (4 * kvh + (row & 3)) * HD + ch * 8) = v; }
    }
}


#define XB_TMO      128
#define XB_XCNT(j)  (256  + 64 * (j))
#define XB_XSUB(j)  (1280 + 64 * (j))
#define XB_XGEN(j)  (2304 + 64 * (j))
#define XB_TOP      3328
#define XB_TOPGEN   3392
#define XCD_BAR_WORDS 3456
#define XB_SPIN_CAP (1u << 18)
__device__ __forceinline__ unsigned xb_ld(unsigned* p)              { return __hip_atomic_load(p, __ATOMIC_RELAXED, __HIP_MEMORY_SCOPE_AGENT); }
__device__ __forceinline__ unsigned xb_add(unsigned* p, unsigned v) { return __hip_atomic_fetch_add(p, v, __ATOMIC_RELAXED, __HIP_MEMORY_SCOPE_AGENT); }
__device__ __forceinline__ unsigned xb_xcc_id() { return (unsigned)__builtin_amdgcn_s_getreg((3 << 11) | 20) & 0xFu; }
#define XB_SPIN(cond, bar) do { unsigned _sp = 0; while (cond) { __builtin_amdgcn_s_sleep(1); \
    if ((++_sp & 255u) == 0u) { if (xb_ld(&(bar)[XB_TMO])) break; if (_sp > XB_SPIN_CAP) { atomicAdd(&(bar)[XB_TMO], 1u); break; } } } } while (0)
struct XcdBarrier { unsigned* bar; unsigned x; volatile LAS unsigned* st; };
__device__ __forceinline__ XcdBarrier xcd_barrier_post(unsigned* bar, volatile LAS unsigned* st) {
    XcdBarrier b; b.bar = bar; b.x = xb_xcc_id(); b.st = st;
    if (threadIdx.x == 0) (void)xb_add(&bar[XB_XCNT(b.x)], 1u);
    return b;
}
__device__ __forceinline__ void xcd_barrier_complete(unsigned* bar, unsigned x, unsigned& nloc, unsigned& nx) {
    const unsigned G = gridDim.x * gridDim.y * gridDim.z;
    unsigned sum, cnt, mine, sp = 0u;
    for (;;) {
        sum = 0u; cnt = 0u; mine = 0u;
#pragma unroll
        for (unsigned j = 0; j < 16; ++j) { const unsigned c = xb_ld(&bar[XB_XCNT(j)]); sum += c; cnt += (c > 0u) ? 1u : 0u; mine = (j == x) ? c : mine; }
        if (sum == G) break;
        __builtin_amdgcn_s_sleep(1);
        if ((++sp & 255u) == 0u) { if (xb_ld(&bar[XB_TMO])) break; if (sp > XB_SPIN_CAP) { atomicAdd(&bar[XB_TMO], 1u); break; } }
    }
    nloc = mine > 0u ? mine : 1u; nx = cnt > 0u ? cnt : 1u;
}
__device__ __forceinline__ void xcd_barrier(const XcdBarrier& b) {
    asm volatile("s_waitcnt vmcnt(0)" ::: "memory");
    __syncthreads();
    if (threadIdx.x == 0) {
        unsigned* bar = b.bar;
        __builtin_amdgcn_s_waitcnt(0);
        unsigned nloc = b.st[0], nx = b.st[1];
        if (nloc == 0u) { xcd_barrier_complete(bar, b.x, nloc, nx); b.st[0] = nloc; b.st[1] = nx; }
        const unsigned old = xb_add(&bar[XB_XSUB(b.x)], 1u);
        const unsigned gen = old / nloc;
        if (old + 1u == (gen + 1u) * nloc) {
            __builtin_amdgcn_fence(__ATOMIC_RELEASE, "agent");
            asm volatile("s_waitcnt vmcnt(0)" ::: "memory");
            const unsigned og = xb_add(&bar[XB_TOP], 1u);
            const unsigned tg = og / nx;
            if (og + 1u == (tg + 1u) * nx) xb_add(&bar[XB_TOPGEN], 1u);
            else XB_SPIN(xb_ld(&bar[XB_TOPGEN]) == tg, bar);
            __builtin_amdgcn_fence(__ATOMIC_ACQUIRE, "agent");
            xb_add(&bar[XB_XGEN(b.x)], 1u);
            asm volatile("s_waitcnt vmcnt(0)" ::: "memory");
        } else {
            XB_SPIN(xb_ld(&bar[XB_XGEN(b.x)]) == gen, bar);
            __builtin_amdgcn_fence(__ATOMIC_ACQUIRE, "agent");
            asm volatile("s_waitcnt vmcnt(0)" ::: "memory");
        }
    }
    __syncthreads();
}

struct Args { const float* in[36]; float* out; unsigned char* ws; };

__global__ void __launch_bounds__(512, 2) mega_fwd(Args a) {
    extern __shared__ __attribute__((aligned(16))) unsigned char smem[];
    ldsp lds = (ldsp)smem;
    const int tid = threadIdx.x, lane = tid & 63, wid = __builtin_amdgcn_readfirstlane(tid >> 6);
    const int G = gridDim.x, bid = blockIdx.x;
    const int gw = bid * 8 + wid, NGW = G * 8, NTH = G * 512;
#define GTID() ((int)(blockIdx.x * 512 + fresh_tid()))
    unsigned char* ws = a.ws;
    float* h = a.out;
    bf16_t* XN = (bf16_t*)(ws + WS_XN); bf16_t* HID = (bf16_t*)(ws + WS_HID);
    bf16_t* W1T = (bf16_t*)(ws + WS_W1T); bf16_t* W2T = (bf16_t*)(ws + WS_W2T);
    bf16_t* WMIX = (bf16_t*)(ws + WS_WMIX);
    LAS float* scr = (LAS float*)(lds + wid * 16384);
    if (tid < 2) ((volatile LAS unsigned*)(lds + LDS_XB))[tid] = 0u;
    __syncthreads();
    const XcdBarrier xbar = xcd_barrier_post((unsigned*)(ws + WS_BAR), (volatile LAS unsigned*)(lds + LDS_XB));
#define GSYNC() xcd_barrier(xbar)
    const int* positions = (const int*)a.in[1];
    float* cosT = (float*)(ws + WS_COS); float* sinT = (float*)(ws + WS_SIN);

#define GEMM(EPI_T, EPI, Aptr, Bptr, M_, N_, K_, LDA_, APN_, ALIGN_, CID_) do { pg8::Gemm g_{(const bf16_t*)(Aptr), (const bf16_t*)(Bptr), (M_), (N_), (K_), (LDA_), (size_t)(APN_)}; pg8::StaticOrder S_; S_.init((M_), (N_), G, (CID_)); \
        pg8::gemm_phase<EPI_T, ALIGN_>(lds, g_, S_, (EPI)); } while (0)
#define CVT_MLP(i1, i2) do { cvt_mat(a.in[i1], D, FF, FF, W1T, D, 0, 0, scr, gw, NGW, lane); cvt_mat(a.in[i2], FF, D, D, W2T, FF, 0, 0, scr, gw, NGW, lane); } while (0)
#define MLP(i) do { \
        { pg8::EpiBf16<1> E_{HID, FF}; GEMM(pg8::EpiBf16<1>, E_, XN, W1T, S, FF, D, D, 0, true, bid); } \
        GSYNC(); \
        { pg8::EpiRes E_{h, h, nullptr}; GEMM(pg8::EpiRes, E_, HID, W2T, S, D, FF, FF, 0, true, bid); } \
        GSYNC(); } while (0)

    cvt_mat(a.in[3], D, 3 * D, 3 * D, WMIX, D, 0, 0, scr, gw, NGW, lane);
    cvt_mat(a.in[4], D, NH, 256, WMIX, D, 3 * D, 0, scr, gw, NGW, lane);
    cvt_mat(a.in[6], D, D, D, (bf16_t*)(ws + WS_WMIX + WM_B), D, 0, 0, scr, gw, NGW, lane);
    for (int it = GTID(); it < S * 8; it += NTH) { const int t = it >> 3, i = it & 7; const float inv = powf(500000.f, -(float)(2 * i) / 16.f); const float ang = (float)positions[t] * inv; cosT[it] = cosf(ang); sinT[it] = sinf(ang); }
    { const int g_ = GTID(); if (g_ < 32) ((unsigned*)(ws + WS_KMAX))[g_] = 0u; }
    norm_phase(a.in[0], a.in[2], XN, gw, NGW, lane);
    GSYNC();
    { pg8::EpiQKV E_{(bf16_t*)(ws + WS_FQ), (bf16_t*)(ws + WS_FK), (bf16_t*)(ws + WS_FV), (float*)(ws + WS_LF), a.in[5], (unsigned*)(ws + WS_KMAX)}; GEMM(pg8::EpiQKV, E_, XN, WMIX, S, NQKV_PAD, D, D, 0, true, bid); }
    if (G == 256) { cvt_mat<64>(a.in[8], D, FF, FF, W1T, D, 0, 0, scr, gw, 192 * 8, lane); cvt_mat<64>(a.in[9], FF, D, D, W2T, FF, 0, 0, scr, gw, 192 * 8, lane); }
    GSYNC();
    for (;;) {
        __syncthreads();
        if (tid == 0) *(volatile LAS unsigned*)(lds + ATT_MISC + 64) = atomicAdd((unsigned*)(ws + WS_BAR + 15 * 1024), 1u);
        __syncthreads();
        const unsigned u = *(volatile LAS unsigned*)(lds + ATT_MISC + 64);
        if (u >= 1024u) break;
        fox_unit(lds, (int)(u & 15u), 63 - (int)(u >> 4), (const bf16_t*)(ws + WS_FQ), (const bf16_t*)(ws + WS_FK), (const bf16_t*)(ws + WS_FV), (bf16_t*)(ws + WS_FO), (const float*)(ws + WS_LF), (const unsigned*)(ws + WS_KMAX), tid, lane, wid);
    }
    __syncthreads();
    if (G != 256) CVT_MLP(8, 9);
    GSYNC();
    { pg8::EpiRes E_{a.in[0], h, nullptr}; GEMM(pg8::EpiRes, E_, ws + WS_FO, ws + WS_WMIX + WM_B, S, D, D, D, 0, true, bid); }
    GSYNC();
    norm_phase(h, a.in[7], XN, gw, NGW, lane);
    GSYNC();
    MLP(0);
    norm_phase(h, a.in[10], XN, gw, NGW, lane);
    for (int g4 = 0; g4 < 4; ++g4) cvt_mat(a.in[11] + (size_t)g4 * 65536, 256, 256, 256, WMIX, 256, g4 * 256, 0, scr, gw, NGW, lane);
    CVT_MLP(14, 15);
    GSYNC();
    pool_diff_phase(XN, (bf16_t*)(ws + WS_PD), 0, NTH);
    GSYNC();
    { pg8::EpiRes E_{h, h, a.in[12]}; GEMM(pg8::EpiRes, E_, ws + WS_PD, WMIX, S, D, 256, 256, (size_t)S * 256 * 2, true, bid); }
    GSYNC();
    norm_phase(h, a.in[13], XN, gw, NGW, lane);
    GSYNC();
    MLP(1);
    norm_phase(h, a.in[16], XN, gw, NGW, lane);
    cvt_mat(a.in[17], D, 3 * D, 3 * D, WMIX, D, 0, 0, scr, gw, NGW, lane);
    cvt_mat(a.in[19], D, D, D, (bf16_t*)(ws + WS_WMIX + WM_B), D, 0, 0, scr, gw, NGW, lane);
    CVT_MLP(21, 22);
    GSYNC();
    { pg8::EpiBf16<0> E_{(bf16_t*)(ws + WS_BCU), 3 * D}; GEMM(pg8::EpiBf16<0>, E_, XN, WMIX, S, 3 * D, D, D, 0, true, bid); }
    GSYNC();
    conv_phase((const bf16_t*)(ws + WS_BCU), a.in[18], (bf16_t*)(ws + WS_CY), 0, NTH);
    GSYNC();
    { pg8::EpiRes E_{h, h, nullptr}; GEMM(pg8::EpiRes, E_, ws + WS_CY, ws + WS_WMIX + WM_B, S, D, D, D, 0, true, bid); }
    GSYNC();
    norm_phase(h, a.in[20], XN, gw, NGW, lane);
    GSYNC();
    MLP(2);
    norm_phase(h, a.in[23], XN, gw, NGW, lane);
    cvt_mat(a.in[24], D, NSA_W, NSA_PAD, WMIX, D, 0, 0, scr, gw, NGW, lane);
#define NSA_AUX(FB, NWV) do { \
        cvt_mat<FB>(a.in[31], D, D, D, (bf16_t*)(ws + WS_WMIX + WM_NSA_WO), D, 0, 0, scr, gw, (NWV), lane); \
        cvt_mat<FB>(a.in[26], 2048, 256, 256, (bf16_t*)(ws + WS_WMIX + WM_NSA_C1K), 2048, 0, 0, scr, gw, (NWV), lane); \
        cvt_mat<FB>(a.in[29], 2048, 256, 256, (bf16_t*)(ws + WS_WMIX + WM_NSA_C1V), 2048, 0, 0, scr, gw, (NWV), lane); \
        cvt_mat<FB>(a.in[27], 256, 64, 256, (bf16_t*)(ws + WS_WMIX + WM_NSA_C2K), 256, 0, 0, scr, gw, (NWV), lane); \
        cvt_mat<FB>(a.in[30], 256, 64, 256, (bf16_t*)(ws + WS_WMIX + WM_NSA_C2V), 256, 0, 0, scr, gw, (NWV), lane); \
        { const int gwx = gw - (FB) * 8;     \
          if (gwx >= 0 && gwx < 512) { const int which = gwx >> 8, c = gwx & 255; const float* pe = a.in[which ? 28 : 25]; const float* w1 = a.in[which ? 29 : 26]; float sacc = 0.f; \
            _Pragma("unroll") for (int kk = 0; kk < 32; ++kk) { const int k = lane + 64 * kk; sacc += pe[k] * w1[(size_t)k * 256 + c]; } \
            sacc = wave_sum(sacc); if (lane == 0) ((float*)(ws + WS_CB))[gwx] = sacc; } } \
        { const int g_ = GTID() - (FB) * 512;     \
          if (g_ >= 0 && g_ < 1024) { ((unsigned*)(ws + WS_KCR + (size_t)4 * S * 64 * 2))[g_] = 0u; ((unsigned*)(ws + WS_VCR + (size_t)4 * S * 64 * 2))[g_] = 0u; } } \
    } while (0)
    if (G != 256) { NSA_AUX(0, NGW); CVT_MLP(33, 34); }
    GSYNC();
    { pg8::EpiNSA E_{(bf16_t*)(ws + WS_NQ), (bf16_t*)(ws + WS_KCR), (bf16_t*)(ws + WS_VCR), (bf16_t*)(ws + WS_KSL), (bf16_t*)(ws + WS_VST), (bf16_t*)(ws + WS_KWN), (bf16_t*)(ws + WS_VWN), (float*)(ws + WS_GAT), cosT, sinT};
      GEMM(pg8::EpiNSA, E_, XN, WMIX, S, NSA_PAD, D, D, 0, true, bid); }
    if (G == 256) NSA_AUX(192, 64 * 8);
    GSYNC();
    { pg8::EpiCmp E_{(bf16_t*)(ws + WS_CH), (const float*)(ws + WS_CB)}; GEMM(pg8::EpiCmp, E_, ws + WS_KCR, ws + WS_WMIX + WM_NSA_C1K, 4096, 256, 2048, 1024, 0, false, bid); }
    { pg8::EpiCmp E_{(bf16_t*)(ws + WS_CH) + 4096 * 256, (const float*)(ws + WS_CB) + 256}; GEMM(pg8::EpiCmp, E_, ws + WS_VCR, ws + WS_WMIX + WM_NSA_C1V, 4096, 256, 2048, 1024, 0, false, (bid + G / 2) % G); }
    if (G == 256) { cvt_mat<144>(a.in[33], D, FF, FF, W1T, D, 0, 0, scr, gw, 112 * 8, lane); cvt_mat<144>(a.in[34], FF, D, D, W2T, FF, 0, 0, scr, gw, 112 * 8, lane); }
    GSYNC();
    { pg8::EpiCmp2<true> E_{(bf16_t*)(ws + WS_KC), cosT, sinT}; GEMM(pg8::EpiCmp2<true>, E_, ws + WS_CH, ws + WS_WMIX + WM_NSA_C2K, 4096, 256, 256, 256, 0, false, bid); }
    { pg8::EpiCmp2<false> E_{(bf16_t*)(ws + WS_VC), cosT, sinT}; GEMM(pg8::EpiCmp2<false>, E_, (bf16_t*)(ws + WS_CH) + 4096 * 256, ws + WS_WMIX + WM_NSA_C2V, 4096, 256, 256, 256, 0, false, (bid + G / 2) % G); }
    GSYNC();
    for (int qn = 0; qn < 4; ++qn) {
        const int kvh = (((bid & 7) >> 1) + qn) & 3;
        for (;;) {
            __syncthreads();
            if (tid == 0) *(volatile LAS unsigned*)(lds + ATT_MISC + 64) = atomicAdd((unsigned*)(ws + WS_BAR + 15 * 1024 + 64 + 64 * kvh), 1u);
            __syncthreads();
            const unsigned u = *(volatile LAS unsigned*)(lds + ATT_MISC + 64);
            if (u >= 256u) break;
            nsa_cs_unit(lds, kvh, 255 - (int)u, (const bf16_t*)(ws + WS_NQ), (const bf16_t*)(ws + WS_KC), (const bf16_t*)(ws + WS_VC), (const bf16_t*)(ws + WS_KSL), (const bf16_t*)(ws + WS_VST), (const bf16_t*)(ws + WS_KWN), (const bf16_t*)(ws + WS_VWN), (const float*)(ws + WS_GAT), (bf16_t*)(ws + WS_O3), tid, lane, wid);
        }
    }
    __syncthreads();
    GSYNC();
    { pg8::EpiRes E_{h, h, nullptr}; GEMM(pg8::EpiRes, E_, ws + WS_O3, ws + WS_WMIX + WM_NSA_WO, S, D, D, D, 0, true, bid); }
    GSYNC();
    norm_phase(h, a.in[32], XN, gw, NGW, lane);
    GSYNC();
    MLP(3);
    final_norm_phase(h, a.in[35], gw, NGW, lane);
    if (a.ws == nullptr) cg::this_grid().sync();
}

extern "C" void kernel_launch(void* const* d_in, const int* in_sizes, int n_in, void* d_out, int out_size, void* d_ws, size_t ws_size, hipStream_t stream) {
    static int grid = 0;
    if (grid == 0) {
        if (n_in != 36 || out_size != S * D || ws_size < WS_END) { fprintf(stderr, "kernel_launch: unexpected shapes (n_in %d out %d ws %zu)\n", n_in, out_size, ws_size); grid = -1; return; }
        int dev = 0, cus = 0, per_cu = 0;
        hipGetDevice(&dev); hipDeviceGetAttribute(&cus, hipDeviceAttributeMultiprocessorCount, dev);
        if (hipFuncSetAttribute((const void*)mega_fwd, hipFuncAttributeMaxDynamicSharedMemorySize, LDS_BYTES) != hipSuccess) { fprintf(stderr, "kernel_launch: hipFuncSetAttribute failed\n"); grid = -1; return; }
        if (hipOccupancyMaxActiveBlocksPerMultiprocessor(&per_cu, (const void*)mega_fwd, 512, LDS_BYTES) != hipSuccess || per_cu < 1) per_cu = 1;
        (void)hipGetLastError();
        grid = cus * (per_cu > 1 ? 1 : per_cu);
    }
    if (grid < 0) return;
    if (hipMemsetAsync((unsigned char*)d_ws + WS_BAR, 0, 16384, stream) != hipSuccess) { fprintf(stderr, "kernel_launch: memset failed\n"); return; }
    Args a{};
    for (int i = 0; i < 36; ++i) a.in[i] = (const float*)d_in[i];
    a.out = (float*)d_out; a.ws = (unsigned char*)d_ws;
    void* args[] = {&a};
    hipError_t e = hipLaunchCooperativeKernel((const void*)mega_fwd, dim3(grid), dim3(512), args, LDS_BYTES, stream);
    if (e != hipSuccess) fprintf(stderr, "cooperative launch failed: %s (grid %d)\n", hipGetErrorString(e), grid);
}
```
